# Optimizing an MI355X kernel written in HIP

```python
import jax, jax.numpy as jnp
from jax import lax
import numpy as np

D_MODEL = 4096
BATCH = 1
SEQ = 8192
DEPTH = 1

GRID_W = 64
CTX_LEN = 256
HEAD_DIM = 128
MIX_WIDTH = D_MODEL
W_SGU = MIX_WIDTH // 2
W_NA = MIX_WIDTH - W_SGU
N_SGU_HEADS = W_SGU // HEAD_DIM
N_NA_HEADS = W_NA // HEAD_DIM
CHUNK = 128
WIN_H = 8
WIN_W = 16
D_FF = ((8 * D_MODEL + 3 * 256 - 1) // (3 * 256)) * 256
IN_COLS = 2 * W_SGU + 3 * W_NA
SPLIT_POINTS = (W_SGU, 2 * W_SGU, 2 * W_SGU + W_NA, 2 * W_SGU + 2 * W_NA)
DEEPNORM_ALPHA = (2.0 * DEPTH) ** 0.25
DEEPNORM_BETA = (8.0 * DEPTH) ** -0.25
LN_EPS = 1e-5
ADA_INIT = 0.5

kernel_name = "hybrid_sgu_natten_dit_block"


def _layer_norm(x, gain, bias):
    xf = x.astype(jnp.float32)
    mu = jnp.mean(xf, axis=-1, keepdims=True)
    var = jnp.mean(jnp.square(xf - mu), axis=-1, keepdims=True)
    y = (xf - mu) * lax.rsqrt(var + LN_EPS)
    if gain is not None:
        y = y * gain.astype(jnp.float32) + bias.astype(jnp.float32)
    return y.astype(x.dtype)


def _rms_norm(x):
    xf = x.astype(jnp.float32)
    return (xf * lax.rsqrt(jnp.mean(jnp.square(xf), axis=-1, keepdims=True) + LN_EPS)).astype(x.dtype)


def _modulation(cond, w_ada, b_ada):
    return jnp.split(jax.nn.silu(cond) @ w_ada + b_ada, 6, axis=-1)


def _heads(t, n_heads):
    return t.reshape(t.shape[:-1] + (n_heads, HEAD_DIM))


def _chunk_spatial_gating(u, v, w_s, b_s, ln_g, ln_b):
    b, length, _ = u.shape
    v = _layer_norm(v, ln_g, ln_b).reshape(b, length // CHUNK, CHUNK, N_SGU_HEADS, HEAD_DIM)
    mixed = jnp.einsum("hpq,bnqhd->bnphd", w_s, v) + b_s.T[None, None, :, :, None]
    return u * mixed.reshape(b, length, W_SGU)


def _neighbourhood_attention(q, k, v, k_ctx, v_ctx, rpb):
    b, s, h, dh = q.shape
    rows = s // GRID_W
    wh = min(WIN_H, rows)
    r = jnp.arange(rows)
    key_rows = jnp.clip(r - wh // 2, 0, rows - wh)[:, None] + jnp.arange(wh)[None, :]
    col = jnp.arange(GRID_W)
    col_start = jnp.clip(col - WIN_W // 2, 0, GRID_W - WIN_W)
    col_mask = (col[None, :] >= col_start[:, None]) & (col[None, :] < col_start[:, None] + WIN_W)
    q = q.reshape(b, rows, GRID_W, h, dh) * (dh ** -0.5)
    k_blk = jnp.take(k.reshape(b, rows, GRID_W, h, dh), key_rows, axis=1)
    v_blk = jnp.take(v.reshape(b, rows, GRID_W, h, dh), key_rows, axis=1)
    s_lat = jnp.einsum("brqhd,brikhd->bhrqik", q, k_blk).astype(jnp.float32)
    d_row = key_rows - r[:, None] + (WIN_H - 1)
    d_col = jnp.clip(col[None, :] - col[:, None], -(WIN_W - 1), WIN_W - 1) + (WIN_W - 1)
    bias = rpb[:, d_row[:, None, :, None], d_col[None, :, None, :]]
    s_lat = jnp.where(col_mask[:, None, :], s_lat + bias.astype(jnp.float32), -jnp.inf)
    s_ctx = jnp.einsum("brqhd,bchd->bhrqc", q, k_ctx).astype(jnp.float32)
    n_lat = wh * GRID_W
    p = jax.nn.softmax(jnp.concatenate([s_lat.reshape(b, h, rows, GRID_W, n_lat), s_ctx], axis=-1), axis=-1).astype(v.dtype)
    p_lat = p[..., :n_lat].reshape(b, h, rows, GRID_W, wh, GRID_W)
    out = jnp.einsum("bhrqik,brikhd->brqhd", p_lat, v_blk) + jnp.einsum("bhrqc,bchd->brqhd", p[..., n_lat:], v_ctx)
    return out.reshape(b, s, h * dh)


def _context_attention(q, k, v):
    s = jnp.einsum("bqhd,bkhd->bhqk", q * (HEAD_DIM ** -0.5), k).astype(jnp.float32)
    p = jax.nn.softmax(s, axis=-1).astype(v.dtype)
    out = jnp.einsum("bhqk,bkhd->bqhd", p, v)
    return out.reshape(out.shape[:2] + (W_NA,))


def _merge(out_a, out_b, gn_g, w_o):
    return (jnp.concatenate([_rms_norm(out_a), _rms_norm(out_b)], axis=-1) * gn_g) @ w_o


def _mixing(h, hc, w_in, w_s, b_s, sgu_g, sgu_b, rpb, gn_g, w_o, update_ctx):
    u, vs, q, k, v = jnp.split(h @ w_in, SPLIT_POINTS, axis=-1)
    if update_ctx:
        uc, vsc, qc, kc, vc = jnp.split(hc @ w_in, SPLIT_POINTS, axis=-1)
    else:
        kc, vc = jnp.split(hc @ w_in[:, SPLIT_POINTS[2]:], 2, axis=-1)
    kc, vc = _heads(kc, N_NA_HEADS), _heads(vc, N_NA_HEADS)
    out_a = _chunk_spatial_gating(jax.nn.gelu(u, approximate=False), jax.nn.gelu(vs, approximate=False),
                                  w_s, b_s, sgu_g, sgu_b)
    out_b = _neighbourhood_attention(_heads(q, N_NA_HEADS), _heads(k, N_NA_HEADS), _heads(v, N_NA_HEADS), kc, vc, rpb)
    y = _merge(out_a, out_b, gn_g, w_o)
    yc = None
    if update_ctx:
        out_ac = _chunk_spatial_gating(jax.nn.gelu(uc, approximate=False), jax.nn.gelu(vsc, approximate=False),
                                       w_s, b_s, sgu_g, sgu_b)
        out_bc = _context_attention(_heads(qc, N_NA_HEADS), kc, vc)
        yc = _merge(out_ac, out_bc, gn_g, w_o)
    return y, yc


def _swiglu(h, w_gate, w_up, w_down):
    return (jax.nn.silu(h @ w_gate) * (h @ w_up)) @ w_down


def setup_inputs(seed: int = 0) -> dict:
    key = jax.random.key(seed)
    ks = jax.random.split(key, 20)
    n = jax.random.normal
    f32 = jnp.float32
    return {
        "x": n(ks[0], (BATCH, SEQ, D_MODEL), f32),
        "c": n(ks[1], (BATCH, D_MODEL), f32),
        "ctx": n(ks[2], (BATCH, CTX_LEN, D_MODEL), f32),
        "c_ctx": n(ks[3], (D_MODEL,), f32),
        "w_ada": n(ks[4], (DEPTH, D_MODEL, 6 * D_MODEL), f32) * (ADA_INIT * D_MODEL ** -0.5),
        "b_ada": n(ks[5], (DEPTH, 6 * D_MODEL), f32) * 0.01,
        "w_in": n(ks[6], (DEPTH, D_MODEL, IN_COLS), f32) * D_MODEL ** -0.5,
        "w_s": n(ks[7], (DEPTH, N_SGU_HEADS, CHUNK, CHUNK), f32) * CHUNK ** -0.5,
        "b_s": 1.0 + 0.01 * n(ks[8], (DEPTH, N_SGU_HEADS, CHUNK), f32),
        "sgu_g": 1.0 + 0.01 * n(ks[9], (DEPTH, W_SGU), f32),
        "sgu_b": 0.01 * n(ks[10], (DEPTH, W_SGU), f32),
        "rpb": 0.1 * n(ks[11], (DEPTH, N_NA_HEADS, 2 * WIN_H - 1, 2 * WIN_W - 1), f32),
        "gn_g": 1.0 + 0.01 * n(ks[12], (DEPTH, MIX_WIDTH), f32),
        "w_o": n(ks[13], (DEPTH, MIX_WIDTH, D_MODEL), f32) * (DEEPNORM_BETA * MIX_WIDTH ** -0.5),
        "ln_g": 1.0 + 0.01 * n(ks[14], (DEPTH, 2, D_MODEL), f32),
        "ln_b": 0.01 * n(ks[15], (DEPTH, 2, D_MODEL), f32),
        "w_gate": n(ks[16], (DEPTH, D_MODEL, D_FF), f32) * D_MODEL ** -0.5,
        "w_up": n(ks[17], (DEPTH, D_MODEL, D_FF), f32) * D_MODEL ** -0.5,
        "w_down": n(ks[18], (DEPTH, D_FF, D_MODEL), f32) * (DEEPNORM_BETA * D_FF ** -0.5),
    }


def reference(x, c, ctx, c_ctx, w_ada, b_ada, w_in, w_s, b_s, sgu_g, sgu_b, rpb, gn_g, w_o, ln_g, ln_b,
              w_gate, w_up, w_down):
    x = _layer_norm(x, None, None)
    ctx = _layer_norm(ctx, None, None)
    alpha = DEEPNORM_ALPHA
    for layer in range(DEPTH):
        update_ctx = layer < DEPTH - 1
        sh1, sc1, g1, sh2, sc2, g2 = _modulation(c[:, None, :], w_ada[layer], b_ada[layer])
        csh1, csc1, cg1, csh2, csc2, cg2 = _modulation(c_ctx[None, None, :], w_ada[layer], b_ada[layer])
        y, yc = _mixing(x * (1 + sc1) + sh1, ctx * (1 + csc1) + csh1, w_in[layer], w_s[layer], b_s[layer],
                        sgu_g[layer], sgu_b[layer], rpb[layer], gn_g[layer], w_o[layer], update_ctx)
        x = _layer_norm(alpha * x + g1 * y, ln_g[layer, 0], ln_b[layer, 0])
        f = _swiglu(x * (1 + sc2) + sh2, w_gate[layer], w_up[layer], w_down[layer])
        x = _layer_norm(alpha * x + g2 * f, ln_g[layer, 1], ln_b[layer, 1])
        if update_ctx:
            ctx = _layer_norm(alpha * ctx + cg1 * yc, ln_g[layer, 0], ln_b[layer, 0])
            fc = _swiglu(ctx * (1 + csc2) + csh2, w_gate[layer], w_up[layer], w_down[layer])
            ctx = _layer_norm(alpha * ctx + cg2 * fc, ln_g[layer, 1], ln_b[layer, 1])
    return x
```

```cpp
#include <hip/hip_runtime.h>
#include <cstdio>
#include <cstdint>

#ifndef MK_N_LAUNCHES
#define MK_N_LAUNCHES 10
#endif

#define LAS __attribute__((address_space(3)))
#define GAS __attribute__((address_space(1)))
typedef unsigned short bf16_t;
typedef short bf16x8 __attribute__((ext_vector_type(8)));
typedef short s16x4 __attribute__((ext_vector_type(4)));
typedef float f32x2 __attribute__((ext_vector_type(2)));
typedef float f32x4 __attribute__((ext_vector_type(4)));
typedef float f32x16 __attribute__((ext_vector_type(16)));
typedef unsigned u32x2 __attribute__((ext_vector_type(2)));
typedef unsigned u32x4 __attribute__((ext_vector_type(4)));

constexpr int SEQ = 8192, DM = 4096, CTXL = 256, HD = 128, NH = 16, WSGU = 2048, NIN = 10240, DFF = 11008, NGU = 2 * DFF;
constexpr float LN_EPS = 1e-5f;
constexpr float DN_ALPHA = 1.189207115002721f;
constexpr int NPHASE = 10;

constexpr size_t MiB = 1u << 20;
constexpr size_t WS_CTL = 0, CTL_ZERO_BYTES = 64 * 1024;
constexpr size_t WS_MOD = 1 * MiB;
constexpr size_t WS_CMOD = WS_MOD + 128 * 1024;
constexpr size_t WS_XSTAT = WS_MOD + 256 * 1024;
constexpr size_t WS_WIN = 2 * MiB;
constexpr size_t WS_WO = 82 * MiB;
constexpr size_t WS_WGU = 114 * MiB;
constexpr size_t WS_WD = 286 * MiB;
constexpr size_t WS_H = 372 * MiB;
constexpr size_t WS_HC = 436 * MiB;
constexpr size_t WS_KVC = 438 * MiB;
constexpr size_t WS_P = 440 * MiB;
constexpr size_t WS_OA = 600 * MiB;
constexpr size_t WS_OB = 632 * MiB;
constexpr size_t WS_AWO = 664 * MiB;
constexpr size_t WS_Z = 728 * MiB;
constexpr size_t WS_ACT = 856 * MiB;
constexpr size_t WS_END = 1028 * MiB;

constexpr int CW_BAR = 1024;

constexpr int RING_BYTES = 131072;
constexpr int MISC_OFF = RING_BYTES + 320;
constexpr int LDS_BYTES = 147456;

__device__ __forceinline__ unsigned f2bf(float f) { unsigned u = __builtin_bit_cast(unsigned, f); return (u + 0x7fffu + ((u >> 16) & 1u)) >> 16; }
__device__ __forceinline__ unsigned pk2(float lo, float hi) { return f2bf(lo) | (f2bf(hi) << 16); }
__device__ __forceinline__ float bflo(unsigned w) { return __builtin_bit_cast(float, w << 16); }
__device__ __forceinline__ float bfhi(unsigned w) { return __builtin_bit_cast(float, w & 0xffff0000u); }
__device__ __forceinline__ float wave_sum(float v) {
#pragma unroll
    for (int o = 1; o < 64; o <<= 1) v += __shfl_xor(v, o);
    return v;
}
#define LDS_WAIT() asm volatile("s_waitcnt lgkmcnt(0)" ::: "memory")
#define VM_WAIT() asm volatile("s_waitcnt vmcnt(0)" ::: "memory")

#define XB_TMO      128
#define XB_XCNT(j)  (256  + 64 * (j))
#define XB_XSUB(j)  (1280 + 64 * (j))
#define XB_XGEN(j)  (2304 + 64 * (j))
#define XB_TOP      3328
#define XB_TOPGEN   3392
#define XCD_BAR_WORDS 3456
#define XB_SPIN_CAP (1u << 18)
__device__ __forceinline__ unsigned xb_ld(unsigned* p)              { return __hip_atomic_load(p, __ATOMIC_RELAXED, __HIP_MEMORY_SCOPE_AGENT); }
__device__ __forceinline__ unsigned xb_add(unsigned* p, unsigned v) { return __hip_atomic_fetch_add(p, v, __ATOMIC_RELAXED, __HIP_MEMORY_SCOPE_AGENT); }
__device__ __forceinline__ unsigned xb_xcc_id() { return (unsigned)__builtin_amdgcn_s_getreg((3 << 11) | 20) & 0xFu; }
#define XB_SPIN(cond, bar) do { unsigned _sp = 0; while (cond) { __builtin_amdgcn_s_sleep(1); \
    if ((++_sp & 255u) == 0u) { if (xb_ld(&(bar)[XB_TMO])) break; if (_sp > XB_SPIN_CAP) { atomicAdd(&(bar)[XB_TMO], 1u); break; } } } } while (0)
struct XcdBarrier { unsigned* bar; unsigned x; volatile LAS unsigned* st; };
__device__ __forceinline__ XcdBarrier xcd_barrier_post(unsigned* bar, volatile LAS unsigned* st) {
    XcdBarrier b; b.bar = bar; b.x = xb_xcc_id(); b.st = st;
    if (threadIdx.x == 0) (void)xb_add(&bar[XB_XCNT(b.x)], 1u);
    return b;
}
__device__ __forceinline__ void xcd_barrier_complete(unsigned* bar, unsigned x, unsigned& nloc, unsigned& nx) {
    const unsigned G = gridDim.x * gridDim.y * gridDim.z;
    unsigned sum, cnt, mine, sp = 0u;
    for (;;) {
        sum = 0u; cnt = 0u; mine = 0u;
#pragma unroll
        for (unsigned j = 0; j < 16; ++j) { const unsigned c = xb_ld(&bar[XB_XCNT(j)]); sum += c; cnt += (c > 0u) ? 1u : 0u; mine = (j == x) ? c : mine; }
        if (sum == G) break;
        __builtin_amdgcn_s_sleep(1);
        if ((++sp & 255u) == 0u) { if (xb_ld(&bar[XB_TMO])) break; if (sp > XB_SPIN_CAP) { atomicAdd(&bar[XB_TMO], 1u); break; } }
    }
    nloc = mine > 0u ? mine : 1u; nx = cnt > 0u ? cnt : 1u;
}
__device__ __forceinline__ void xcd_barrier(const XcdBarrier& b) {
    asm volatile("s_waitcnt vmcnt(0)" ::: "memory");
    __syncthreads();
    if (threadIdx.x == 0) {
        unsigned* bar = b.bar;
        __builtin_amdgcn_s_waitcnt(0);
        unsigned nloc = b.st[0], nx = b.st[1];
        if (nloc == 0u) { xcd_barrier_complete(bar, b.x, nloc, nx); b.st[0] = nloc; b.st[1] = nx; }
        const unsigned old = xb_add(&bar[XB_XSUB(b.x)], 1u);
        const unsigned gen = old / nloc;
        if (old + 1u == (gen + 1u) * nloc) {
            __builtin_amdgcn_fence(__ATOMIC_RELEASE, "agent");
            asm volatile("s_waitcnt vmcnt(0)" ::: "memory");
            const unsigned og = xb_add(&bar[XB_TOP], 1u);
            const unsigned tg = og / nx;
            if (og + 1u == (tg + 1u) * nx) xb_add(&bar[XB_TOPGEN], 1u);
            else XB_SPIN(xb_ld(&bar[XB_TOPGEN]) == tg, bar);
            __builtin_amdgcn_fence(__ATOMIC_ACQUIRE, "agent");
            xb_add(&bar[XB_XGEN(b.x)], 1u);
            asm volatile("s_waitcnt vmcnt(0)" ::: "memory");
        } else {
            XB_SPIN(xb_ld(&bar[XB_XGEN(b.x)]) == gen, bar);
            __builtin_amdgcn_fence(__ATOMIC_ACQUIRE, "agent");
            asm volatile("s_waitcnt vmcnt(0)" ::: "memory");
        }
    }
    __syncthreads();
}

namespace pg8 {
constexpr int BM = 256, BK = 64, HALF = 128, HTB = HALF * BK * 2, STAGE_BYTES = 8 * HTB, NXCD = 8, WGM = 8;
__host__ __device__ __forceinline__ int lds_byte(int r, int c) { const int st = (r >> 4) * 2 + (c >> 5), rr = r & 15, cc = c & 31, ob = rr * 64 + cc * 2; return st * 1024 + (ob ^ (((ob >> 9) & 1) << 5)); }
__host__ __device__ __forceinline__ void stage_rc(int b, int& R, int& C) { const int st = b / 1024, sb = b % 1024, swz = sb ^ (((sb >> 9) & 1) << 5); R = (st >> 1) * 16 + swz / 64; C = (st & 1) * 32 + (swz % 64) / 2; }
__host__ __device__ __forceinline__ int perm32(int rho) { const int n = rho >> 4, i = rho & 15; return 8 * (i >> 2) + 4 * n + (i & 3); }
struct Unit { int pm, pn; };
struct Gemm { const bf16_t* A; const bf16_t* Bt; int M, N, K; };
struct StaticOrder {
    int nM, nN, nwg, G, c;
    __host__ __device__ void init(int M, int N, int G_, int c_) { nM = M / BM; nN = N / BM; nwg = nM * nN; G = G_; c = c_; }
    __host__ __device__ bool next(int i, Unit& u) const {
        const long L = (long)i * G + c; if (L >= nwg) return false;
        int wgid = (int)L; { const int q = nwg / NXCD, r = nwg % NXCD, xcd = wgid % NXCD, off = wgid / NXCD; wgid = (xcd < r ? xcd * (q + 1) : r * (q + 1) + (xcd - r) * q) + off; }
        const int nig = WGM * nN, gid = wgid / nig, fm = gid * WGM, gsz = (nM - fm) < WGM ? (nM - fm) : WGM;
        u.pm = fm + ((wgid % nig) % gsz); u.pn = (wgid % nig) / gsz; return true;
    }
    __device__ __forceinline__ void a_ready(const Unit&) const {}
    __device__ __forceinline__ void done(const Unit&) const {}
};
__device__ __forceinline__ unsigned cvt_pk_bf16(float lo, float hi) { unsigned r; asm volatile("v_cvt_pk_bf16_f32 %0, %1, %2" : "=v"(r) : "v"(lo), "v"(hi)); return r; }
__device__ __forceinline__ f32x2 gelu_pk(f32x2 v) {
    const f32x2 av = __builtin_elementwise_abs(v), d = av * 0.2316418882f + 1.0f;
    f32x2 t; t.x = __builtin_amdgcn_rcpf(d.x); t.y = __builtin_amdgcn_rcpf(d.y);
    f32x2 q = t * 0.5307027145f + (-0.7265760135f); q = q * t + 0.7107068705f; q = q * t + (-0.142248368f); q = q * t + 0.127414796f; q = q * t;
    const f32x2 s = (v * v) * (-0.72134752044f);
    f32x2 e; e.x = __builtin_amdgcn_exp2f(s.x); e.y = __builtin_amdgcn_exp2f(s.y);
    const f32x2 m = v * (q * e), r = v - m;
    f32x2 o; o.x = v.x < 0.f ? m.x : r.x; o.y = v.y < 0.f ? m.y : r.y; return o;
}
__device__ __forceinline__ float silu_f(float g) { return g * __builtin_amdgcn_rcpf(1.0f + __builtin_amdgcn_exp2f(-1.4426950408889634f * g)); }

struct EpiProj {
    static constexpr bool PERM = true, AFTER_DRAIN = false;
    bf16_t* O; int ldc; int gelu_tiles;
    __device__ __forceinline__ void operator()(const f32x4 (&acc)[2][2][4][2], const Unit& u, int wr, int wc, int fr, int fq) const {
        const int row0 = u.pm * BM + wr * 64 + fr, col0 = u.pn * BM + wc * 32 + 8 * fq; const bool g = u.pn < gelu_tiles;
#pragma unroll
        for (int ai = 0; ai < 2; ++ai)
#pragma unroll
            for (int m = 0; m < 4; ++m) { bf16_t* rowp = O + (size_t)(row0 + ai * HALF + m * 16) * ldc + col0;
#pragma unroll
                for (int bj = 0; bj < 2; ++bj) { f32x4 v0 = acc[ai][bj][m][0], v1 = acc[ai][bj][m][1];
                    if (g) { f32x2 a = gelu_pk((f32x2){v0[0], v0[1]}), b = gelu_pk((f32x2){v0[2], v0[3]}), c = gelu_pk((f32x2){v1[0], v1[1]}), d = gelu_pk((f32x2){v1[2], v1[3]});
                        v0 = (f32x4){a.x, a.y, b.x, b.y}; v1 = (f32x4){c.x, c.y, d.x, d.y}; }
                    u32x4 w; w.x = cvt_pk_bf16(v0[0], v0[1]); w.y = cvt_pk_bf16(v0[2], v0[3]); w.z = cvt_pk_bf16(v1[0], v1[1]); w.w = cvt_pk_bf16(v1[2], v1[3]);
                    *(u32x4*)(rowp + bj * HALF) = w; } }
    }
};
struct EpiSwiglu {
    static constexpr bool PERM = true, AFTER_DRAIN = false;
    bf16_t* O; int ldc;
    __device__ __forceinline__ void operator()(const f32x4 (&acc)[2][2][4][2], const Unit& u, int wr, int wc, int fr, int fq) const {
        const int row0 = u.pm * BM + wr * 64 + fr, col0 = u.pn * HALF + wc * 32 + 8 * fq;
#pragma unroll
        for (int ai = 0; ai < 2; ++ai)
#pragma unroll
            for (int m = 0; m < 4; ++m) { bf16_t* rowp = O + (size_t)(row0 + ai * HALF + m * 16) * ldc + col0;
                const f32x4 g0 = acc[ai][0][m][0], g1 = acc[ai][0][m][1], u0 = acc[ai][1][m][0], u1 = acc[ai][1][m][1];
                u32x4 w; w.x = cvt_pk_bf16(silu_f(g0[0]) * u0[0], silu_f(g0[1]) * u0[1]); w.y = cvt_pk_bf16(silu_f(g0[2]) * u0[2], silu_f(g0[3]) * u0[3]);
                w.z = cvt_pk_bf16(silu_f(g1[0]) * u1[0], silu_f(g1[1]) * u1[1]); w.w = cvt_pk_bf16(silu_f(g1[2]) * u1[2], silu_f(g1[3]) * u1[3]);
                *(u32x4*)rowp = w; }
    }
};
template <bool FROM_X> struct EpiRes {
    static constexpr bool PERM = false, AFTER_DRAIN = false;
    const float* base; const float* stat; const float* gvec; float* out;
    __device__ __forceinline__ void operator()(const f32x4 (&acc)[2][2][4][2], const Unit& u, int wr, int wc, int fr, int fq) const {
        const int row0 = u.pm * BM + wr * 64 + fr, col0 = u.pn * BM + wc * 32 + 4 * fq;
        f32x4 gv[2][2];
#pragma unroll
        for (int bj = 0; bj < 2; ++bj)
#pragma unroll
            for (int n = 0; n < 2; ++n) gv[bj][n] = *(const f32x4*)(gvec + col0 + bj * HALF + n * 16);
#pragma unroll
        for (int ai = 0; ai < 2; ++ai)
#pragma unroll
            for (int m = 0; m < 4; ++m) { const int row = row0 + ai * HALF + m * 16; float mean = 0.f, rstd = 1.f;
                if (FROM_X) { const f32x2 s = *(const f32x2*)(stat + 2 * row); mean = s.x; rstd = s.y; }
                const size_t off = (size_t)row * DM + col0;
#pragma unroll
                for (int bj = 0; bj < 2; ++bj)
#pragma unroll
                    for (int n = 0; n < 2; ++n) { f32x4 b = *(const f32x4*)(base + off + bj * HALF + n * 16); if (FROM_X) b = (b - mean) * rstd;
                        *(f32x4*)(out + off + bj * HALF + n * 16) = b * DN_ALPHA + gv[bj][n] * acc[ai][bj][m][n]; }
                asm volatile("" ::: "memory"); }
    }
};

template <class Epi, class Sched, bool ALIGN_EPI = false, bool SP2 = false>
__device__ __forceinline__ void gemm_phase(LAS unsigned char* lds, const Gemm g, const Sched& S, const Epi& E) {
    const int tid = threadIdx.x, wid = __builtin_amdgcn_readfirstlane(tid >> 6), lane = tid & 63, wr = wid >> 2, wc = wid & 3, fr = lane & 15, fq = lane >> 4;
    const int K = g.K, nt = K / BK;
    unsigned voffA[2], voffB[2];
#pragma unroll
    for (int i = 0; i < 2; ++i) { int R, C; stage_rc(tid * 16 + i * 8192, R, C); const int Rb = Epi::PERM ? ((R & ~31) + perm32(R & 31)) : R;
        voffA[i] = (unsigned)(R * K + C) * 2u; voffB[i] = (unsigned)(Rb * K + C) * 2u; }
    const size_t kstep = (size_t)(BK * 2);
    const size_t hstep = (size_t)HALF * K * 2;
    const size_t tstep = 2 * hstep;
    const unsigned ldsw = (unsigned)wid * 1024u;
    const int aoff = lds_byte(wr * 64 + fr, fq * 8), boff = lds_byte(wc * 32 + fr, fq * 8);
#define PG8_SA(b, h) (((b) * 2 + (h)) * HTB)
#define PG8_SB(b, h) ((4 + (b) * 2 + (h)) * HTB)
#define PG8_STAGE(bufoff, gbase, voff) do { _Pragma("unroll") for (int _i = 0; _i < 2; ++_i) \
        __builtin_amdgcn_global_load_lds((const unsigned*)((const char*)(gbase) + (voff)[_i]), (LAS unsigned*)(lds + (bufoff) + ldsw + _i * 8192), 16, 0, 0); } while (0)
#define PG8_LDA(dst, b, h) do { _Pragma("unroll") for (int m = 0; m < 4; ++m) _Pragma("unroll") for (int k = 0; k < 2; ++k) dst[m][k] = *(const LAS bf16x8*)(lds + PG8_SA(b, h) + aoff + m * 2048 + k * 1024); } while (0)
#define PG8_LDB(dst, b, h) do { _Pragma("unroll") for (int n = 0; n < 2; ++n) _Pragma("unroll") for (int k = 0; k < 2; ++k) dst[n][k] = *(const LAS bf16x8*)(lds + PG8_SB(b, h) + boff + n * 2048 + k * 1024); } while (0)
#define PG8_MMA(ai, bj, At, Bt) do { __builtin_amdgcn_s_setprio(1); _Pragma("unroll") for (int m = 0; m < 4; ++m) _Pragma("unroll") for (int n = 0; n < 2; ++n) _Pragma("unroll") for (int k = 0; k < 2; ++k) \
        acc[ai][bj][m][n] = __builtin_amdgcn_mfma_f32_16x16x32_bf16(Bt[n][k], At[m][k], acc[ai][bj][m][n], 0, 0, 0); __builtin_amdgcn_s_setprio(0); } while (0)
#define PG8_WAIT_V(n) asm volatile("s_waitcnt vmcnt(" #n ")" ::: "memory")
#define PG8_WAIT_L(n) asm volatile("s_waitcnt lgkmcnt(" #n ")" ::: "memory")
#define PG8_BAR __builtin_amdgcn_s_barrier()
#define PG8_SCHED __builtin_amdgcn_sched_barrier(0)
    Unit cur, nxt; int ui = 0;
    if (!S.next(0, cur)) return;
    f32x4 acc[2][2][4][2];
#pragma unroll
    for (int a = 0; a < 2; ++a)
#pragma unroll
        for (int b = 0; b < 2; ++b)
#pragma unroll
            for (int m = 0; m < 4; ++m)
#pragma unroll
                for (int n = 0; n < 2; ++n) acc[a][b][m][n] = (f32x4){0.f, 0.f, 0.f, 0.f};
    bf16x8 At[4][2], B0[2][2], B1[2][2];
    const char* cA = (const char*)g.A + (size_t)cur.pm * tstep; const char* cB = (const char*)g.Bt + (size_t)cur.pn * tstep;
    S.a_ready(cur);
    if constexpr (SP2) {
        PG8_STAGE(PG8_SB(0, 0), cB, voffB); PG8_STAGE(PG8_SB(0, 1), cB + hstep, voffB); PG8_STAGE(PG8_SA(0, 0), cA, voffA); PG8_STAGE(PG8_SA(0, 1), cA + hstep, voffA);
        if (wr == 1) PG8_BAR;
        PG8_WAIT_V(2); PG8_BAR;
        PG8_STAGE(PG8_SB(1, 0), cB + kstep, voffB); PG8_STAGE(PG8_SA(1, 0), cA + kstep, voffA); PG8_STAGE(PG8_SB(1, 1), cB + hstep + kstep, voffB);
        PG8_WAIT_V(6); PG8_BAR;
    } else {
        PG8_STAGE(PG8_SB(0, 0), cB, voffB); PG8_STAGE(PG8_SA(0, 0), cA, voffA); PG8_STAGE(PG8_SB(0, 1), cB + hstep, voffB); PG8_STAGE(PG8_SA(0, 1), cA + hstep, voffA);
        if (wr == 1) PG8_BAR;
        PG8_WAIT_V(4); PG8_BAR;
        PG8_STAGE(PG8_SB(1, 0), cB + kstep, voffB); PG8_STAGE(PG8_SA(1, 0), cA + kstep, voffA); PG8_STAGE(PG8_SB(1, 1), cB + hstep + kstep, voffB);
        PG8_WAIT_V(6); PG8_BAR;
    }
    for (;;) {
        const bool has_next = S.next(ui + 1, nxt);
        const char* nA = has_next ? (const char*)g.A + (size_t)nxt.pm * tstep : cA; const char* nB = has_next ? (const char*)g.Bt + (size_t)nxt.pn * tstep : cB;
        for (int t = 0; t < nt; t += 2) {
            const bool last = (t == nt - 2);
            const char* a1 = cA + (size_t)(t + 1) * kstep;
            const char* a2 = last ? nA : cA + (size_t)(t + 2) * kstep; const char* b2 = last ? nB : cB + (size_t)(t + 2) * kstep;
            const char* a3 = a2 + kstep; const char* b3 = b2 + kstep;
            if (last && has_next) S.a_ready(nxt);
            if constexpr (SP2) {
            PG8_LDB(B0, 0, 0); PG8_LDB(B1, 0, 1); PG8_SCHED; PG8_LDA(At, 0, 0); PG8_STAGE(PG8_SA(1, 1), a1 + hstep, voffA);
            PG8_WAIT_V(8); PG8_WAIT_L(0); PG8_BAR; PG8_MMA(0, 0, At, B0); PG8_MMA(0, 1, At, B1); PG8_BAR; PG8_SCHED;
            PG8_LDA(At, 0, 1); PG8_STAGE(PG8_SB(0, 0), b2, voffB); PG8_STAGE(PG8_SB(0, 1), b2 + hstep, voffB); PG8_STAGE(PG8_SA(0, 0), a2, voffA);
            PG8_WAIT_V(8); PG8_WAIT_L(0); PG8_BAR; PG8_MMA(1, 0, At, B0); PG8_MMA(1, 1, At, B1); PG8_BAR; PG8_SCHED;
            PG8_LDB(B0, 1, 0); PG8_LDB(B1, 1, 1); PG8_SCHED; PG8_LDA(At, 1, 0); PG8_STAGE(PG8_SA(0, 1), a2 + hstep, voffA);
            PG8_WAIT_V(8); PG8_WAIT_L(0); PG8_BAR; PG8_MMA(0, 0, At, B0); PG8_MMA(0, 1, At, B1); PG8_BAR; PG8_SCHED;
            PG8_LDA(At, 1, 1); PG8_STAGE(PG8_SB(1, 0), b3, voffB); PG8_STAGE(PG8_SB(1, 1), b3 + hstep, voffB); PG8_STAGE(PG8_SA(1, 0), a3, voffA);
            PG8_WAIT_V(8); PG8_WAIT_L(0); PG8_BAR; PG8_MMA(1, 0, At, B0); PG8_MMA(1, 1, At, B1); PG8_BAR; PG8_SCHED;
            } else {
            PG8_LDB(B0, 0, 0); PG8_SCHED; PG8_LDA(At, 0, 0); PG8_STAGE(PG8_SA(1, 1), a1 + hstep, voffA);
            PG8_WAIT_L(8); PG8_BAR; PG8_WAIT_L(0); PG8_MMA(0, 0, At, B0); PG8_BAR; PG8_SCHED;
            PG8_LDB(B1, 0, 1); PG8_STAGE(PG8_SB(0, 0), b2, voffB);
            PG8_BAR; PG8_WAIT_L(0); PG8_MMA(0, 1, At, B1); PG8_BAR;
            PG8_LDA(At, 0, 1); PG8_STAGE(PG8_SA(0, 0), a2, voffA);
            PG8_BAR; PG8_WAIT_L(0); PG8_MMA(1, 0, At, B0); PG8_BAR; PG8_SCHED;
            PG8_STAGE(PG8_SB(0, 1), b2 + hstep, voffB);
            PG8_WAIT_V(6); PG8_BAR; PG8_MMA(1, 1, At, B1); PG8_BAR;
            PG8_LDB(B0, 1, 0); PG8_SCHED; PG8_LDA(At, 1, 0); PG8_STAGE(PG8_SA(0, 1), a2 + hstep, voffA);
            PG8_WAIT_L(8); PG8_BAR; PG8_WAIT_L(0); PG8_MMA(0, 0, At, B0); PG8_BAR; PG8_SCHED;
            PG8_LDB(B1, 1, 1); PG8_STAGE(PG8_SB(1, 0), b3, voffB);
            PG8_BAR; PG8_WAIT_L(0); PG8_MMA(0, 1, At, B1); PG8_BAR;
            PG8_LDA(At, 1, 1); PG8_STAGE(PG8_SA(1, 0), a3, voffA);
            PG8_BAR; PG8_WAIT_L(0); PG8_MMA(1, 0, At, B0); PG8_BAR; PG8_SCHED;
            PG8_STAGE(PG8_SB(1, 1), b3 + hstep, voffB);
            PG8_WAIT_V(6); PG8_BAR; PG8_MMA(1, 1, At, B1); PG8_BAR;
            }
        }
        if constexpr (ALIGN_EPI) { if (wr == 0) PG8_BAR; }
        if constexpr (!Epi::AFTER_DRAIN) { E(acc, cur, wr, wc, fr, fq); S.done(cur); }
        if (!has_next) break;
#pragma unroll
        for (int a = 0; a < 2; ++a)
#pragma unroll
            for (int b = 0; b < 2; ++b)
#pragma unroll
                for (int m = 0; m < 4; ++m)
#pragma unroll
                    for (int n = 0; n < 2; ++n) acc[a][b][m][n] = (f32x4){0.f, 0.f, 0.f, 0.f};
        cur = nxt; cA = nA; cB = nB; ++ui;
        if constexpr (ALIGN_EPI) { if (wr == 1) PG8_BAR; }
    }
    PG8_WAIT_V(0);
    if constexpr (!ALIGN_EPI) { if (wr == 0) PG8_BAR; }
    PG8_BAR;
#undef PG8_SA
#undef PG8_SB
#undef PG8_STAGE
#undef PG8_LDA
#undef PG8_LDB
#undef PG8_MMA
#undef PG8_WAIT_V
#undef PG8_WAIT_L
#undef PG8_BAR
#undef PG8_SCHED
}
}

struct Frame {
    LAS unsigned char* lds;
    int tid, lane, wave, bid, G;
    const float *x, *c, *ctx, *c_ctx, *w_ada, *b_ada, *w_in, *w_s, *b_s, *sgu_g, *sgu_b, *rpb, *gn_g, *w_o, *ln_g, *ln_b, *w_gate, *w_up, *w_down;
    float* out;
    float *MOD, *CMOD, *XSTAT, *Z;
    bf16_t *WinT, *WoT, *WguT, *WdT, *H, *HC, *KVC, *P, *OA, *OB, *AWO, *ACT;
};

template <int MODE>
__device__ __forceinline__ void transpose_item(const float* W, int K, int N, bf16_t* WT, int row_off, LAS float* scr, int item, int lane) {
    const int nblk = N / 32, kb = item / nblk, nb = item % nblk, k0 = 64 * kb, n0 = 32 * nb;
#pragma unroll 8
    for (int i = 0; i < 32; ++i) { const int kk = 2 * i + (lane >> 5); scr[kk * 33 + (lane & 31)] = W[(size_t)(k0 + kk) * N + n0 + (lane & 31)]; }
    LDS_WAIT(); asm volatile("" ::: "memory");
    const int c = lane & 7;
#pragma unroll
    for (int j = 0; j < 4; ++j) { const int n = (lane >> 3) + 8 * j; const LAS float* s = scr + (8 * c) * 33 + n;
        u32x4 o; o.x = pk2(s[0 * 33], s[1 * 33]); o.y = pk2(s[2 * 33], s[3 * 33]); o.z = pk2(s[4 * 33], s[5 * 33]); o.w = pk2(s[6 * 33], s[7 * 33]);
        const int nn = n0 + n; const int orow = MODE == 1 ? ((nn >> 7) * 256 + (nn & 127) + row_off) : (nn + row_off);
        *(GAS u32x4*)(WT + (size_t)orow * K + k0 + 8 * c) = o; }
    LDS_WAIT(); asm volatile("" ::: "memory");
}

__device__ __forceinline__ void phase0(Frame& F) {
    {
        LAS float* sc = (LAS float*)F.lds;
        LAS float* sx = sc + 4096;
        LAS float* red = sx + 4096;
        for (int i = F.tid; i < DM; i += 512) { const float a = F.c[i], b = F.c_ctx[i]; sc[i] = a / (1.0f + expf(-a)); sx[i] = b / (1.0f + expf(-b)); }
        __syncthreads();
        for (int u = F.bid; u < 256; u += F.G) {
            const int col0 = u * 96;
            if (F.tid < 384) {
                const int cg = F.tid % 24, kl = F.tid / 24, col = col0 + 4 * cg; const bool doctx = col < 2 * DM;
                f32x4 a = {0.f, 0.f, 0.f, 0.f}, b = {0.f, 0.f, 0.f, 0.f};
                const float* wp = F.w_ada + (size_t)kl * (6 * DM) + col;
                for (int i = 0; i < 256; i += 8) {
                    f32x4 w[8];
#pragma unroll
                    for (int q = 0; q < 8; ++q) w[q] = *(const f32x4*)(wp + (size_t)(i + q) * 16 * (6 * DM));
#pragma unroll
                    for (int q = 0; q < 8; ++q) { const int k = kl + 16 * (i + q); a += w[q] * sc[k]; if (doctx) b += w[q] * sx[k]; }
                }
                *(LAS f32x4*)(red + kl * 192 + 4 * cg) = a; *(LAS f32x4*)(red + kl * 192 + 96 + 4 * cg) = b;
            }
            __syncthreads();
            if (F.tid < 192) {
                float s = 0.f;
#pragma unroll
                for (int kl = 0; kl < 16; ++kl) s += red[kl * 192 + F.tid];
                const int cc = col0 + (F.tid < 96 ? F.tid : F.tid - 96);
                if (F.tid < 96) F.MOD[cc] = s + F.b_ada[cc];
                else if (cc < 2 * DM) F.CMOD[cc] = s + F.b_ada[cc];
            }
            __syncthreads();
        }
    }
    {
        LAS float* scr = (LAS float*)(F.lds + F.wave * 16384);
        const int gw = F.bid * 8 + F.wave, NGW = F.G * 8;
        constexpr int I_IN = (DM / 64) * (NIN / 32), I_O = (DM / 64) * (DM / 32), I_G = (DM / 64) * (DFF / 32), I_D = (DFF / 64) * (DM / 32);
        constexpr int NITEMS = I_IN + I_O + 2 * I_G + I_D;
        for (int it = gw; it < NITEMS; it += NGW) {
            int r = it;
            if (r < I_IN) { transpose_item<0>(F.w_in, DM, NIN, F.WinT, 0, scr, r, F.lane); continue; } r -= I_IN;
            if (r < I_O) { transpose_item<0>(F.w_o, DM, DM, F.WoT, 0, scr, r, F.lane); continue; } r -= I_O;
            if (r < I_G) { transpose_item<1>(F.w_gate, DM, DFF, F.WguT, 0, scr, r, F.lane); continue; } r -= I_G;
            if (r < I_G) { transpose_item<1>(F.w_up, DM, DFF, F.WguT, 128, scr, r, F.lane); continue; } r -= I_G;
            transpose_item<0>(F.w_down, DFF, DM, F.WdT, 0, scr, r, F.lane);
        }
    }
}

__device__ __forceinline__ void ln_rows_p1(Frame& F) {
    LAS float* sh = (LAS float*)F.lds;
    LAS float* sc = sh + DM;
    LAS float* csh = sc + DM;
    LAS float* csc = csh + DM;
    for (int i = F.tid; i < DM; i += 512) { sh[i] = F.MOD[i]; sc[i] = 1.0f + F.MOD[DM + i]; csh[i] = F.CMOD[i]; csc[i] = 1.0f + F.CMOD[DM + i]; }
    __syncthreads();
    const int gw = F.bid * 8 + F.wave, NGW = F.G * 8;
    for (int m = gw; m < SEQ + CTXL; m += NGW) {
        const bool isx = m < SEQ;
        const float* src = isx ? F.x + (size_t)m * DM : F.ctx + (size_t)(m - SEQ) * DM;
        bf16_t* dst = isx ? F.H + (size_t)m * DM : F.HC + (size_t)(m - SEQ) * DM;
        const LAS float* shp = isx ? sh : csh; const LAS float* scp = isx ? sc : csc;
        const f32x4* xr = (const f32x4*)src + F.lane;
        f32x4 v[16]; float s = 0.f;
#pragma unroll
        for (int j = 0; j < 16; ++j) { v[j] = xr[64 * j]; s += (v[j].x + v[j].y) + (v[j].z + v[j].w); }
        const float mean = wave_sum(s) * (1.f / DM); float s2 = 0.f;
#pragma unroll
        for (int j = 0; j < 16; ++j) { v[j] = v[j] - mean; s2 += (v[j].x * v[j].x + v[j].y * v[j].y) + (v[j].z * v[j].z + v[j].w * v[j].w); }
        const float rstd = 1.f / sqrtf(wave_sum(s2) * (1.f / DM) + LN_EPS);
        if (isx && F.lane == 0) { F.XSTAT[2 * m] = mean; F.XSTAT[2 * m + 1] = rstd; }
        u32x2* o8 = (u32x2*)dst + F.lane;
#pragma unroll
        for (int j = 0; j < 16; ++j) { const int col = 4 * (F.lane + 64 * j); const f32x4 a = *(const LAS f32x4*)(scp + col), b = *(const LAS f32x4*)(shp + col);
            const f32x4 h = v[j] * rstd * a + b; u32x2 w; w.x = pk2(h.x, h.y); w.y = pk2(h.z, h.w); o8[64 * j] = w; asm volatile("" ::: "memory"); }
    }
}
__device__ __forceinline__ void ln_rows_p6(Frame& F) {
    LAS float* lg = (LAS float*)F.lds; LAS float* lb = lg + DM; LAS float* sh = lb + DM; LAS float* sc = sh + DM;
    for (int i = F.tid; i < DM; i += 512) { lg[i] = F.ln_g[i]; lb[i] = F.ln_b[i]; sh[i] = F.MOD[3 * DM + i]; sc[i] = 1.0f + F.MOD[4 * DM + i]; }
    __syncthreads();
    const int gw = F.bid * 8 + F.wave, NGW = F.G * 8;
    for (int m = gw; m < SEQ; m += NGW) {
        f32x4* zr = (f32x4*)(F.Z + (size_t)m * DM) + F.lane;
        f32x4 v[16]; float s = 0.f;
#pragma unroll
        for (int j = 0; j < 16; ++j) { v[j] = zr[64 * j]; s += (v[j].x + v[j].y) + (v[j].z + v[j].w); }
        const float mean = wave_sum(s) * (1.f / DM); float s2 = 0.f;
#pragma unroll
        for (int j = 0; j < 16; ++j) { v[j] = v[j] - mean; s2 += (v[j].x * v[j].x + v[j].y * v[j].y) + (v[j].z * v[j].z + v[j].w * v[j].w); }
        const float rstd = 1.f / sqrtf(wave_sum(s2) * (1.f / DM) + LN_EPS);
        u32x2* o8 = (u32x2*)(F.H + (size_t)m * DM) + F.lane;
#pragma unroll
        for (int j = 0; j < 16; ++j) { const int col = 4 * (F.lane + 64 * j);
            const f32x4 x1 = v[j] * rstd * *(const LAS f32x4*)(lg + col) + *(const LAS f32x4*)(lb + col);
            zr[64 * j] = x1;
            const f32x4 h = x1 * *(const LAS f32x4*)(sc + col) + *(const LAS f32x4*)(sh + col); u32x2 w; w.x = pk2(h.x, h.y); w.y = pk2(h.z, h.w); o8[64 * j] = w;
            asm volatile("" ::: "memory"); }
    }
}
__device__ __forceinline__ void ln_rows_p9(Frame& F) {
    LAS float* lg = (LAS float*)F.lds; LAS float* lb = lg + DM;
    for (int i = F.tid; i < DM; i += 512) { lg[i] = F.ln_g[DM + i]; lb[i] = F.ln_b[DM + i]; }
    __syncthreads();
    const int gw = F.bid * 8 + F.wave, NGW = F.G * 8;
    for (int m = gw; m < SEQ; m += NGW) {
        f32x4* zr = (f32x4*)(F.out + (size_t)m * DM) + F.lane;
        f32x4 v[16]; float s = 0.f;
#pragma unroll
        for (int j = 0; j < 16; ++j) { v[j] = zr[64 * j]; s += (v[j].x + v[j].y) + (v[j].z + v[j].w); }
        const float mean = wave_sum(s) * (1.f / DM); float s2 = 0.f;
#pragma unroll
        for (int j = 0; j < 16; ++j) { v[j] = v[j] - mean; s2 += (v[j].x * v[j].x + v[j].y * v[j].y) + (v[j].z * v[j].z + v[j].w * v[j].w); }
        const float rstd = 1.f / sqrtf(wave_sum(s2) * (1.f / DM) + LN_EPS);
#pragma unroll
        for (int j = 0; j < 16; ++j) { const int col = 4 * (F.lane + 64 * j);
            zr[64 * j] = v[j] * rstd * *(const LAS f32x4*)(lg + col) + *(const LAS f32x4*)(lb + col); asm volatile("" ::: "memory"); }
    }
}
__device__ __forceinline__ void merge_rows(Frame& F) {
    const int gw = F.bid * 8 + F.wave, NGW = F.G * 8;
    for (int m = gw; m < SEQ; m += NGW) {
#pragma unroll
        for (int part = 0; part < 2; ++part) {
            const u32x4* src = (const u32x4*)((part ? F.OB : F.OA) + (size_t)m * WSGU) + F.lane;
            u32x4 w[4]; float f[32]; float s2 = 0.f;
#pragma unroll
            for (int j = 0; j < 4; ++j) w[j] = src[64 * j];
#pragma unroll
            for (int j = 0; j < 4; ++j)
#pragma unroll
                for (int e = 0; e < 4; ++e) { const float a = bflo(w[j][e]), b = bfhi(w[j][e]); f[8 * j + 2 * e] = a; f[8 * j + 2 * e + 1] = b; s2 += a * a + b * b; }
            const float r = 1.f / sqrtf(wave_sum(s2) * (1.f / WSGU) + LN_EPS);
            u32x4* dst = (u32x4*)(F.AWO + (size_t)m * DM + part * WSGU) + F.lane;
#pragma unroll
            for (int j = 0; j < 4; ++j) { const float* gp = F.gn_g + part * WSGU + 8 * (F.lane + 64 * j); const f32x4 g0 = *(const f32x4*)gp, g1 = *(const f32x4*)(gp + 4);
                u32x4 o; o.x = pk2(f[8 * j + 0] * r * g0.x, f[8 * j + 1] * r * g0.y); o.y = pk2(f[8 * j + 2] * r * g0.z, f[8 * j + 3] * r * g0.w);
                o.z = pk2(f[8 * j + 4] * r * g1.x, f[8 * j + 5] * r * g1.y); o.w = pk2(f[8 * j + 6] * r * g1.z, f[8 * j + 7] * r * g1.w);
                dst[64 * j] = o; }
        }
    }
}

__device__ __forceinline__ int crow(int r, int hi) { return (r & 3) + 8 * (r >> 2) + 4 * hi; }
__device__ __forceinline__ void sgu_unit(Frame& F, int n, int hg) {
    const int tid = F.tid, wid = F.wave, lane = F.lane, r = lane & 31, hf = lane >> 5;
    LAS f32x2* stat = (LAS f32x2*)F.lds;
    LAS bf16_t* VT = (LAS bf16_t*)(F.lds + 1024);
    __syncthreads();
    for (int i = 0; i < 16; ++i) {
        const int q = 16 * wid + i;
        const u32x4* rp = (const u32x4*)(F.P + (size_t)(128 * n + q) * NIN + WSGU) + lane;
        u32x4 w[4]; float f[32]; float s = 0.f;
#pragma unroll
        for (int j = 0; j < 4; ++j) w[j] = rp[64 * j];
#pragma unroll
        for (int j = 0; j < 4; ++j)
#pragma unroll
            for (int e = 0; e < 4; ++e) { f[8 * j + 2 * e] = bflo(w[j][e]); f[8 * j + 2 * e + 1] = bfhi(w[j][e]); s += f[8 * j + 2 * e] + f[8 * j + 2 * e + 1]; }
        const float mean = wave_sum(s) * (1.f / WSGU); float s2 = 0.f;
#pragma unroll
        for (int e = 0; e < 32; ++e) { const float d = f[e] - mean; s2 += d * d; }
        const float rstd = 1.f / sqrtf(wave_sum(s2) * (1.f / WSGU) + LN_EPS);
        if (lane == 0) stat[q] = (f32x2){mean, rstd};
    }
    __syncthreads();
    const int pb = wid & 3, dh = wid >> 2, p = 32 * pb + r;
    for (int hh = 0; hh < 4; ++hh) {
        const int h = 4 * hg + hh;
        {
            const int q = tid >> 2, dseg = (tid & 3) * 32;
            const u32x4* sp = (const u32x4*)(F.P + (size_t)(128 * n + q) * NIN + WSGU + 128 * h + dseg);
            u32x4 w[4];
#pragma unroll
            for (int j = 0; j < 4; ++j) w[j] = sp[j];
            const f32x2 st = stat[q];
#pragma unroll
            for (int j = 0; j < 4; ++j)
#pragma unroll
                for (int e = 0; e < 4; ++e) { const int d = dseg + 8 * j + 2 * e;
                    const float g0 = F.sgu_g[128 * h + d], g1 = F.sgu_g[128 * h + d + 1], b0 = F.sgu_b[128 * h + d], b1 = F.sgu_b[128 * h + d + 1];
                    const float a = (bflo(w[j][e]) - st.x) * st.y * g0 + b0, b = (bfhi(w[j][e]) - st.x) * st.y * g1 + b1;
                    VT[d * 136 + q] = (bf16_t)f2bf(a); VT[(d + 1) * 136 + q] = (bf16_t)f2bf(b); }
        }
        bf16x8 wsf[8];
        {
            const float* wp = F.w_s + ((size_t)h * 128 + p) * 128 + 8 * hf;
#pragma unroll
            for (int s = 0; s < 8; ++s) { const f32x4 a = *(const f32x4*)(wp + 16 * s), b = *(const f32x4*)(wp + 16 * s + 4);
                u32x4 w; w.x = pk2(a.x, a.y); w.y = pk2(a.z, a.w); w.z = pk2(b.x, b.y); w.w = pk2(b.z, b.w); wsf[s] = __builtin_bit_cast(bf16x8, w); }
        }
        __syncthreads();
        f32x16 acc[2];
#pragma unroll
        for (int db = 0; db < 2; ++db) {
            acc[db] = (f32x16){0.f, 0.f, 0.f, 0.f, 0.f, 0.f, 0.f, 0.f, 0.f, 0.f, 0.f, 0.f, 0.f, 0.f, 0.f, 0.f};
            const int d0 = 64 * dh + 32 * db;
#pragma unroll
            for (int s = 0; s < 8; ++s) { const bf16x8 a = *(const LAS bf16x8*)(VT + (d0 + r) * 136 + 16 * s + 8 * hf);
                acc[db] = __builtin_amdgcn_mfma_f32_32x32x16_bf16(a, wsf[s], acc[db], 0, 0, 0); }
        }
        const float bsp = F.b_s[h * 128 + p]; const size_t row = (size_t)(128 * n + p);
#pragma unroll
        for (int db = 0; db < 2; ++db)
#pragma unroll
            for (int g = 0; g < 4; ++g) { const int d = 64 * dh + 32 * db + 8 * g + 4 * hf;
                const u32x2 uu = *(const u32x2*)(F.P + row * NIN + 128 * h + d);
                const float o0 = bflo(uu.x) * (acc[db][4 * g + 0] + bsp), o1 = bfhi(uu.x) * (acc[db][4 * g + 1] + bsp), o2 = bflo(uu.y) * (acc[db][4 * g + 2] + bsp), o3 = bfhi(uu.y) * (acc[db][4 * g + 3] + bsp);
                u32x2 w; w.x = pk2(o0, o1); w.y = pk2(o2, o3); *(u32x2*)(F.OA + row * WSGU + 128 * h + d) = w; }
        __syncthreads();
    }
}

namespace na {
constexpr float SCALE = 0.088388347648318440f;
constexpr float C = SCALE * 1.4426950408889634f;
#define KSWZ(row, colB) ((row) * 256 + ((colB) ^ (((row) & 7) << 4)))
#define SBAR() __builtin_amdgcn_sched_barrier(0)
__device__ __forceinline__ unsigned cvtpk(float lo, float hi) { unsigned r; asm volatile("v_cvt_pk_bf16_f32 %0, %1, %2" : "=v"(r) : "v"(lo), "v"(hi)); return r; }
__device__ __forceinline__ void partialSM(f32x16& p0, f32x16& p1, float& m_reg, float& mn, float& alpha) {
    float pmax = p0[0];
#pragma unroll
    for (int r = 1; r < 16; ++r) pmax = fmaxf(pmax, p0[r]);
#pragma unroll
    for (int r = 0; r < 16; ++r) pmax = fmaxf(pmax, p1[r]);
    { auto rr = __builtin_amdgcn_permlane32_swap(__float_as_uint(pmax), __float_as_uint(pmax), false, false);
      pmax = fmaxf(__uint_as_float(rr[0]), __uint_as_float(rr[1])); }
    if (__all(pmax - m_reg <= 0.f)) { mn = m_reg; alpha = 1.f; }
    else { mn = fmaxf(m_reg, pmax); alpha = __builtin_amdgcn_exp2f((m_reg - mn) * C); m_reg = mn; }
    const float mnC = -mn * C;
#pragma unroll
    for (int r = 0; r < 16; ++r) p0[r] = fmaf(p0[r], C, mnC);
#pragma unroll
    for (int r = 0; r < 16; ++r) p1[r] = fmaf(p1[r], C, mnC);
#pragma unroll
    for (int r = 0; r < 16; ++r) p0[r] = __builtin_amdgcn_exp2f(p0[r]);
}
__device__ __forceinline__ void finishSM(f32x16& p0, f32x16& p1, float alpha, float& l_reg, bf16x8& pa0, bf16x8& pa1, bf16x8& pa2, bf16x8& pa3) {
#pragma unroll
    for (int r = 0; r < 16; ++r) p1[r] = __builtin_amdgcn_exp2f(p1[r]);
    float ps = 0;
#pragma unroll
    for (int r = 0; r < 16; ++r) ps += p0[r];
#pragma unroll
    for (int r = 0; r < 16; ++r) ps += p1[r];
    { auto rr = __builtin_amdgcn_permlane32_swap(__float_as_uint(ps), __float_as_uint(ps), false, false);
      ps = __uint_as_float(rr[0]) + __uint_as_float(rr[1]); }
    l_reg = l_reg * alpha + ps;
#define PK4(P, BASE, OUT) do { unsigned a0 = cvtpk(P[BASE + 0], P[BASE + 1]), a1 = cvtpk(P[BASE + 2], P[BASE + 3]);   \
    unsigned b0 = cvtpk(P[BASE + 4], P[BASE + 5]), b1 = cvtpk(P[BASE + 6], P[BASE + 7]);                              \
    auto r0 = __builtin_amdgcn_permlane32_swap(a0, b0, false, false); auto r1 = __builtin_amdgcn_permlane32_swap(a1, b1, false, false); \
    u32x4 w = {r0[0], r1[0], r0[1], r1[1]}; OUT = __builtin_bit_cast(bf16x8, w); } while (0)
    PK4(p0, 0, pa0); PK4(p0, 8, pa1); PK4(p1, 0, pa2); PK4(p1, 8, pa3);
#undef PK4
}
__device__ __forceinline__ void qkt(f32x16& p0, f32x16& p1, const LAS char* Ks, const bf16x8* qr, int r32, int hi) {
    p0 = (f32x16){0.f, 0.f, 0.f, 0.f, 0.f, 0.f, 0.f, 0.f, 0.f, 0.f, 0.f, 0.f, 0.f, 0.f, 0.f, 0.f}; p1 = p0;
#pragma unroll
    for (int d0 = 0; d0 < 8; ++d0) { const int cb = (d0 * 16 + hi * 8) * 2;
        const bf16x8 b0 = *(const LAS bf16x8*)(Ks + KSWZ(r32, cb));
        const bf16x8 b1 = *(const LAS bf16x8*)(Ks + KSWZ(32 + r32, cb));
        p0 = __builtin_amdgcn_mfma_f32_32x32x16_bf16(b0, qr[d0], p0, 0, 0, 0);
        p1 = __builtin_amdgcn_mfma_f32_32x32x16_bf16(b1, qr[d0], p1, 0, 0, 0); }
}
__device__ __forceinline__ int v_st(int k, int c) { const int kk = (k & ~0xC) | ((k & 4) << 1) | ((k & 8) >> 1); return ((kk >> 3) * 4 + (c >> 5)) * 512 + ((kk & 7) * 32 + (c & 31)) * 2; }
__device__ __forceinline__ int v_rd_base(int lane) { return ((lane & 3) << 3) | (((lane >> 2) & 3) << 6) | (((lane >> 4) & 1) << 5) | (((lane >> 5) & 1) << 8); }
constexpr int v_rd_off(int d0, int ks, int half) { return d0 * 512 + ks * 4096 + half * 2048; }
template <int OFF> __device__ __forceinline__ s16x4 tr_read(int vb) {
    s16x4 r; asm volatile("ds_read_b64_tr_b16 %0, %1 offset:%2" : "=&v"(r) : "v"(vb), "i"(OFF) : "memory"); return r;
}
template <int D0> __device__ __forceinline__ void pv_one(f32x16& od, int vb, bf16x8 pa0, bf16x8 pa1, bf16x8 pa2, bf16x8 pa3) {
    const s16x4 l0 = tr_read<v_rd_off(D0, 0, 0)>(vb), h0 = tr_read<v_rd_off(D0, 0, 1)>(vb), l1 = tr_read<v_rd_off(D0, 1, 0)>(vb), h1 = tr_read<v_rd_off(D0, 1, 1)>(vb);
    const s16x4 l2 = tr_read<v_rd_off(D0, 2, 0)>(vb), h2 = tr_read<v_rd_off(D0, 2, 1)>(vb), l3 = tr_read<v_rd_off(D0, 3, 0)>(vb), h3 = tr_read<v_rd_off(D0, 3, 1)>(vb);
    asm volatile("s_waitcnt lgkmcnt(0)" ::: "memory"); SBAR();
#define PK(L, H) (bf16x8){L[0], L[1], L[2], L[3], H[0], H[1], H[2], H[3]}
    od = __builtin_amdgcn_mfma_f32_32x32x16_bf16(pa0, PK(l0, h0), od, 0, 0, 0);
    od = __builtin_amdgcn_mfma_f32_32x32x16_bf16(pa1, PK(l1, h1), od, 0, 0, 0);
    od = __builtin_amdgcn_mfma_f32_32x32x16_bf16(pa2, PK(l2, h2), od, 0, 0, 0);
    od = __builtin_amdgcn_mfma_f32_32x32x16_bf16(pa3, PK(l3, h3), od, 0, 0, 0);
#undef PK
}
__device__ __forceinline__ void pv_d0(f32x16* o, int vb, bf16x8 pa0, bf16x8 pa1, bf16x8 pa2, bf16x8 pa3) {
    pv_one<0>(o[0], vb, pa0, pa1, pa2, pa3); pv_one<1>(o[1], vb, pa0, pa1, pa2, pa3); pv_one<2>(o[2], vb, pa0, pa1, pa2, pa3); pv_one<3>(o[3], vb, pa0, pa1, pa2, pa3);
}
}

__device__ __forceinline__ void na_unit(Frame& F, int rg, int h) {
    using namespace na;
    const int tid = F.tid, wid = F.wave, lane = F.lane, r32 = lane & 31, hi = lane >> 5;
    LAS char* V_lds = (LAS char*)F.lds; LAS char* K_lds = V_lds + 16384;
    LAS float* wsc = (LAS float*)(V_lds + 32768) + wid * 64; LAS float* li_l = wsc; LAS float* al_l = wsc + 32;
    LAS float* tbl = (LAS float*)(V_lds + 34816);
    const int rq = 4 * rg + (wid >> 1), ch = wid & 1;
    const int wstart = min(max(rq - 4, 0), 120);
    const int lo = min(max(4 * rg - 4, 0), 120), hirow = min(max(4 * rg - 1, 0), 120) + 7, nlat = hirow - lo + 1;
    __syncthreads();
    for (int i = tid; i < 15 * 32; i += 512) { const int dr = i >> 5, dc = i & 31; tbl[i] = dc < 31 ? F.rpb[(h * 15 + dr) * 31 + dc] * 11.313708498984761f : 0.f; }
    bf16x8 qr[8];
    { const bf16_t* Qw = F.P + (size_t)(64 * rq + 32 * ch + r32) * NIN + 2 * WSGU + 128 * h + hi * 8;
#pragma unroll
      for (int d0 = 0; d0 < 8; ++d0) qr[d0] = *(const bf16x8*)(Qw + d0 * 16); }
    float m_reg = -1e30f, l_reg = 0.f;
    f32x16 o[4];
#pragma unroll
    for (int d = 0; d < 4; ++d) o[d] = (f32x16){0.f, 0.f, 0.f, 0.f, 0.f, 0.f, 0.f, 0.f, 0.f, 0.f, 0.f, 0.f, 0.f, 0.f, 0.f, 0.f};
    const int sr = tid >> 4, sc = (tid & 15) * 8, vst0 = v_st(sr, sc), vst1 = v_st(32 + sr, sc);
    const int vb0 = (int)(size_t)V_lds + v_rd_base(lane);
    const int qc = 32 * ch + r32, cs = min(max(qc - 8, 0), 48);
    for (int j = 0; j < nlat + 4; ++j) {
        const bool lat = j < nlat; const int kr = lo + j;
        __syncthreads();
        {
            const bf16_t* ks; size_t pitch;
            if (lat) { ks = F.P + (size_t)(64 * kr) * NIN + 3 * WSGU + 128 * h; pitch = NIN; }
            else { ks = F.KVC + (size_t)(64 * (j - nlat)) * DM + 128 * h; pitch = DM; }
            const bf16_t* vs = ks + WSGU;
            const bf16x8 k0 = *(const bf16x8*)(ks + (size_t)sr * pitch + sc), k1 = *(const bf16x8*)(ks + (size_t)(32 + sr) * pitch + sc);
            const bf16x8 v0 = *(const bf16x8*)(vs + (size_t)sr * pitch + sc), v1 = *(const bf16x8*)(vs + (size_t)(32 + sr) * pitch + sc);
            *(LAS bf16x8*)(V_lds + vst0) = v0; *(LAS bf16x8*)(V_lds + vst1) = v1;
            *(LAS bf16x8*)(K_lds + KSWZ(sr, sc * 2)) = k0; *(LAS bf16x8*)(K_lds + KSWZ(32 + sr, sc * 2)) = k1;
        }
        __syncthreads();
        const bool active = lat ? (kr >= wstart && kr < wstart + 8) : true;
        if (active) {
            f32x16 p0, p1; qkt(p0, p1, K_lds, qr, r32, hi);
            if (lat) {
                const int dr32 = (kr - rq + 7) * 32;
#pragma unroll
                for (int r = 0; r < 16; ++r) {
                    const int kc0 = crow(r, hi), kc1 = kc0 + 32;
                    const bool v0 = (unsigned)(kc0 - cs) < 16u, v1 = (unsigned)(kc1 - cs) < 16u;
                    const float b0 = tbl[v0 ? dr32 + (kc0 - qc + 15) : 0], b1 = tbl[v1 ? dr32 + (kc1 - qc + 15) : 0];
                    p0[r] = v0 ? p0[r] + b0 : -1e30f; p1[r] = v1 ? p1[r] + b1 : -1e30f;
                }
            }
            float mn, alpha; partialSM(p0, p1, m_reg, mn, alpha);
            if (__any(alpha < 1.f)) { if (hi == 0) al_l[r32] = alpha; LDS_WAIT();
#pragma unroll
                for (int d = 0; d < 4; ++d)
#pragma unroll
                    for (int r = 0; r < 16; ++r) o[d][r] *= al_l[crow(r, hi)]; }
            bf16x8 pa0, pa1, pa2, pa3; finishSM(p0, p1, alpha, l_reg, pa0, pa1, pa2, pa3); SBAR();
            pv_d0(o, vb0, pa0, pa1, pa2, pa3);
        }
    }
    if (hi == 0) li_l[r32] = l_reg; LDS_WAIT();
    float rli[16];
#pragma unroll
    for (int r = 0; r < 16; ++r) rli[r] = 1.0f / li_l[crow(r, hi)];
    bf16_t* Ow = F.OB + (size_t)(64 * rq + 32 * ch) * WSGU + 128 * h;
#pragma unroll
    for (int r = 0; r < 16; ++r) { const int orow = crow(r, hi);
#pragma unroll
        for (int d0 = 0; d0 < 4; ++d0) Ow[(size_t)orow * WSGU + d0 * 32 + r32] = (bf16_t)f2bf(o[d0][r] * rli[r]); }
}

struct Args { const float* in[19]; float* out; unsigned char* ws; int ph_lo, ph_hi; };
__global__ void __launch_bounds__(512, 2) fwd(Args args) {
    extern __shared__ __attribute__((aligned(16))) unsigned char lds_raw[];
    Frame F;
    F.lds = (LAS unsigned char*)lds_raw;
    F.tid = threadIdx.x; F.lane = F.tid & 63; F.wave = __builtin_amdgcn_readfirstlane(F.tid >> 6); F.bid = blockIdx.x; F.G = gridDim.x;
    unsigned char* ws = args.ws;
    F.x = args.in[0]; F.c = args.in[1]; F.ctx = args.in[2]; F.c_ctx = args.in[3]; F.w_ada = args.in[4]; F.b_ada = args.in[5]; F.w_in = args.in[6]; F.w_s = args.in[7]; F.b_s = args.in[8];
    F.sgu_g = args.in[9]; F.sgu_b = args.in[10]; F.rpb = args.in[11]; F.gn_g = args.in[12]; F.w_o = args.in[13]; F.ln_g = args.in[14]; F.ln_b = args.in[15]; F.w_gate = args.in[16]; F.w_up = args.in[17]; F.w_down = args.in[18];
    F.out = args.out;
    F.MOD = (float*)(ws + WS_MOD); F.CMOD = (float*)(ws + WS_CMOD); F.XSTAT = (float*)(ws + WS_XSTAT); F.Z = (float*)(ws + WS_Z);
    F.WinT = (bf16_t*)(ws + WS_WIN); F.WoT = (bf16_t*)(ws + WS_WO); F.WguT = (bf16_t*)(ws + WS_WGU); F.WdT = (bf16_t*)(ws + WS_WD);
    F.H = (bf16_t*)(ws + WS_H); F.HC = (bf16_t*)(ws + WS_HC); F.KVC = (bf16_t*)(ws + WS_KVC); F.P = (bf16_t*)(ws + WS_P);
    F.OA = (bf16_t*)(ws + WS_OA); F.OB = (bf16_t*)(ws + WS_OB); F.AWO = (bf16_t*)(ws + WS_AWO); F.ACT = (bf16_t*)(ws + WS_ACT);
    volatile LAS unsigned* MISC = (volatile LAS unsigned*)(F.lds + MISC_OFF);
    if (F.tid < 32) MISC[F.tid] = 0u;
    __syncthreads();
    const int lo = args.ph_lo, hi = args.ph_hi;
    XcdBarrier bar; bar.bar = (unsigned*)(ws + WS_CTL) + CW_BAR; bar.x = 0; bar.st = nullptr;
    if (hi - lo > 1) bar = xcd_barrier_post((unsigned*)(ws + WS_CTL) + CW_BAR, MISC + 8);
#define IN(k) (lo <= (k) && (k) < hi)
#define SEAM(k) do { if (IN(k) && IN((k) + 1)) xcd_barrier(bar); } while (0)

    if (IN(0)) { phase0(F); } SEAM(0);
    if (IN(1)) { ln_rows_p1(F); } SEAM(1);
    if (IN(2)) {
        { pg8::Gemm g{F.H, F.WinT, SEQ, NIN, DM}; pg8::StaticOrder S; S.init(SEQ, NIN, F.G, F.bid); pg8::EpiProj E{F.P, NIN, 16};
          pg8::gemm_phase<pg8::EpiProj, pg8::StaticOrder, true, true>(F.lds, g, S, E); }
        { pg8::Gemm g{F.HC, F.WinT + (size_t)(3 * WSGU) * DM, CTXL, 2 * WSGU, DM}; pg8::StaticOrder S; S.init(CTXL, 2 * WSGU, F.G, F.bid); pg8::EpiProj E{F.KVC, DM, 0};
          pg8::gemm_phase<pg8::EpiProj, pg8::StaticOrder, true, true>(F.lds, g, S, E); }
    } SEAM(2);
    if (IN(3)) {
        for (int u = F.bid; u < 256; u += F.G) sgu_unit(F, u >> 2, u & 3);
        for (int u = F.bid; u < 512; u += F.G) na_unit(F, u >> 4, u & 15);
    } SEAM(3);
    if (IN(4)) { merge_rows(F); } SEAM(4);
    if (IN(5)) { pg8::Gemm g{F.AWO, F.WoT, SEQ, DM, DM}; pg8::StaticOrder S; S.init(SEQ, DM, F.G, F.bid); pg8::EpiRes<true> E{F.x, F.XSTAT, F.MOD + 2 * DM, F.Z};
        pg8::gemm_phase<pg8::EpiRes<true>, pg8::StaticOrder, true, true>(F.lds, g, S, E); } SEAM(5);
    if (IN(6)) { ln_rows_p6(F); } SEAM(6);
    if (IN(7)) { pg8::Gemm g{F.H, F.WguT, SEQ, NGU, DM}; pg8::StaticOrder S; S.init(SEQ, NGU, F.G, F.bid); pg8::EpiSwiglu E{F.ACT, DFF};
        pg8::gemm_phase<pg8::EpiSwiglu, pg8::StaticOrder, true, true>(F.lds, g, S, E); } SEAM(7);
    if (IN(8)) { pg8::Gemm g{F.ACT, F.WdT, SEQ, DM, DFF}; pg8::StaticOrder S; S.init(SEQ, DM, F.G, F.bid); pg8::EpiRes<false> E{F.Z, nullptr, F.MOD + 5 * DM, F.out};
        pg8::gemm_phase<pg8::EpiRes<false>, pg8::StaticOrder, true, true>(F.lds, g, S, E); } SEAM(8);
    if (IN(9)) { ln_rows_p9(F); }
#undef IN
#undef SEAM
}

extern "C" void kernel_launch(void* const* d_in, const int* in_sizes, int n_in, void* d_out, int out_size, void* d_ws, size_t ws_size, hipStream_t stream) {
    static int grid = 0;
    if (grid == 0) {
        if (n_in != 19 || out_size != SEQ * DM || ws_size < WS_END) { fprintf(stderr, "kernel_launch: unexpected shapes (n_in %d out %d ws %zu)\n", n_in, out_size, ws_size); grid = -1; return; }
        int dev = 0, cus = 0;
        if (hipGetDevice(&dev) != hipSuccess || hipDeviceGetAttribute(&cus, hipDeviceAttributeMultiprocessorCount, dev) != hipSuccess) { grid = -1; return; }
        if (hipFuncSetAttribute((const void*)fwd, hipFuncAttributeMaxDynamicSharedMemorySize, LDS_BYTES) != hipSuccess) { fprintf(stderr, "kernel_launch: hipFuncSetAttribute failed\n"); grid = -1; return; }
        int per_cu = 0;
        if (hipOccupancyMaxActiveBlocksPerMultiprocessor(&per_cu, (const void*)fwd, 512, LDS_BYTES) != hipSuccess || per_cu < 1) fprintf(stderr, "kernel_launch: occupancy query says %d\n", per_cu);
        (void)hipGetLastError();
        grid = cus;
    }
    if (grid < 0) return;
    (void)hipMemsetAsync((char*)d_ws + WS_CTL, 0, CTL_ZERO_BYTES, stream);
    Args a{};
    for (int i = 0; i < 19; ++i) a.in[i] = (const float*)d_in[i];
    a.out = (float*)d_out; a.ws = (unsigned char*)d_ws;
    constexpr int NL = MK_N_LAUNCHES;
    if (NL == 1) { a.ph_lo = 0; a.ph_hi = NPHASE; hipLaunchKernelGGL(fwd, dim3(grid), dim3(512), LDS_BYTES, stream, a); }
    else { for (int p = 0; p < NPHASE; ++p) { a.ph_lo = p; a.ph_hi = p + 1; hipLaunchKernelGGL(fwd, dim3(grid), dim3(512), LDS_BYTES, stream, a); } }
    const hipError_t le = hipPeekAtLastError();
    if (le != hipSuccess) fprintf(stderr, "kernel_launch: launch failed: %s\n", hipGetErrorName(le));
}
```

```cpp
#include <hip/hip_runtime.h>
#include <cstdio>
#include <cstdint>

#ifndef MK_N_LAUNCHES
#define MK_N_LAUNCHES 1
#endif

#define LAS __attribute__((address_space(3)))
#define GAS __attribute__((address_space(1)))
typedef unsigned short bf16_t;
typedef short bf16x8 __attribute__((ext_vector_type(8)));
typedef short s16x4 __attribute__((ext_vector_type(4)));
typedef float f32x2 __attribute__((ext_vector_type(2)));
typedef float f32x4 __attribute__((ext_vector_type(4)));
typedef float f32x16 __attribute__((ext_vector_type(16)));
typedef unsigned u32x2 __attribute__((ext_vector_type(2)));
typedef unsigned u32x4 __attribute__((ext_vector_type(4)));

constexpr int SEQ = 8192, DM = 4096, CTXL = 256, HD = 128, NH = 16, WSGU = 2048, NIN = 10240, DFF = 11008, NGU = 2 * DFF;
constexpr float LN_EPS = 1e-5f;
constexpr float DN_ALPHA = 1.189207115002721f;
constexpr int NPHASE = 10;

constexpr size_t MiB = 1u << 20;
constexpr size_t WS_CTL = 0, CTL_ZERO_BYTES = 64 * 1024;
constexpr size_t WS_MOD = 1 * MiB;
constexpr size_t WS_CMOD = WS_MOD + 128 * 1024;
constexpr size_t WS_XSTAT = WS_MOD + 256 * 1024;
constexpr size_t WS_WIN = 2 * MiB;
constexpr size_t WS_WO = 82 * MiB;
constexpr size_t WS_WGU = 114 * MiB;
constexpr size_t WS_WD = 286 * MiB;
constexpr size_t WS_H = 372 * MiB;
constexpr size_t WS_HC = 436 * MiB;
constexpr size_t WS_KVC = 438 * MiB;
constexpr size_t WS_P = 440 * MiB;
constexpr size_t WS_OA = 600 * MiB;
constexpr size_t WS_OB = 632 * MiB;
constexpr size_t WS_AWO = 664 * MiB;
constexpr size_t WS_Z = 728 * MiB;
constexpr size_t WS_ACT = 856 * MiB;
constexpr size_t WS_END = 1028 * MiB;

constexpr int CW_BAR = 1024;

constexpr int RING_BYTES = 131072;
constexpr int MISC_OFF = RING_BYTES + 320;
constexpr int LDS_BYTES = 147456;

__device__ __forceinline__ unsigned f2bf(float f) { unsigned u = __builtin_bit_cast(unsigned, f); return (u + 0x7fffu + ((u >> 16) & 1u)) >> 16; }
__device__ __forceinline__ unsigned pk2(float lo, float hi) { return f2bf(lo) | (f2bf(hi) << 16); }
__device__ __forceinline__ float bflo(unsigned w) { return __builtin_bit_cast(float, w << 16); }
__device__ __forceinline__ float bfhi(unsigned w) { return __builtin_bit_cast(float, w & 0xffff0000u); }
__device__ __forceinline__ float wave_sum(float v) {
#pragma unroll
    for (int o = 1; o < 64; o <<= 1) v += __shfl_xor(v, o);
    return v;
}
#define LDS_WAIT() asm volatile("s_waitcnt lgkmcnt(0)" ::: "memory")
#define VM_WAIT() asm volatile("s_waitcnt vmcnt(0)" ::: "memory")

#define XB_TMO      128
#define XB_XCNT(j)  (256  + 64 * (j))
#define XB_XSUB(j)  (1280 + 64 * (j))
#define XB_XGEN(j)  (2304 + 64 * (j))
#define XB_TOP      3328
#define XB_TOPGEN   3392
#define XCD_BAR_WORDS 3456
#define XB_SPIN_CAP (1u << 18)
__device__ __forceinline__ unsigned xb_ld(unsigned* p)              { return __hip_atomic_load(p, __ATOMIC_RELAXED, __HIP_MEMORY_SCOPE_AGENT); }
__device__ __forceinline__ unsigned xb_add(unsigned* p, unsigned v) { return __hip_atomic_fetch_add(p, v, __ATOMIC_RELAXED, __HIP_MEMORY_SCOPE_AGENT); }
__device__ __forceinline__ unsigned xb_xcc_id() { return (unsigned)__builtin_amdgcn_s_getreg((3 << 11) | 20) & 0xFu; }
#define XB_SPIN(cond, bar) do { unsigned _sp = 0; while (cond) { __builtin_amdgcn_s_sleep(1); \
    if ((++_sp & 255u) == 0u) { if (xb_ld(&(bar)[XB_TMO])) break; if (_sp > XB_SPIN_CAP) { atomicAdd(&(bar)[XB_TMO], 1u); break; } } } } while (0)
struct XcdBarrier { unsigned* bar; unsigned x; volatile LAS unsigned* st; };
__device__ __forceinline__ XcdBarrier xcd_barrier_post(unsigned* bar, volatile LAS unsigned* st) {
    XcdBarrier b; b.bar = bar; b.x = xb_xcc_id(); b.st = st;
    if (threadIdx.x == 0) (void)xb_add(&bar[XB_XCNT(b.x)], 1u);
    return b;
}
__device__ __forceinline__ void xcd_barrier_complete(unsigned* bar, unsigned x, unsigned& nloc, unsigned& nx) {
    const unsigned G = gridDim.x * gridDim.y * gridDim.z;
    unsigned sum, cnt, mine, sp = 0u;
    for (;;) {
        sum = 0u; cnt = 0u; mine = 0u;
#pragma unroll
        for (unsigned j = 0; j < 16; ++j) { const unsigned c = xb_ld(&bar[XB_XCNT(j)]); sum += c; cnt += (c > 0u) ? 1u : 0u; mine = (j == x) ? c : mine; }
        if (sum == G) break;
        __builtin_amdgcn_s_sleep(1);
        if ((++sp & 255u) == 0u) { if (xb_ld(&bar[XB_TMO])) break; if (sp > XB_SPIN_CAP) { atomicAdd(&bar[XB_TMO], 1u); break; } }
    }
    nloc = mine > 0u ? mine : 1u; nx = cnt > 0u ? cnt : 1u;
}
__device__ __forceinline__ void xcd_barrier(const XcdBarrier& b) {
    asm volatile("s_waitcnt vmcnt(0)" ::: "memory");
    __syncthreads();
    if (threadIdx.x == 0) {
        unsigned* bar = b.bar;
        __builtin_amdgcn_s_waitcnt(0);
        unsigned nloc = b.st[0], nx = b.st[1];
        if (nloc == 0u) { xcd_barrier_complete(bar, b.x, nloc, nx); b.st[0] = nloc; b.st[1] = nx; }
        const unsigned old = xb_add(&bar[XB_XSUB(b.x)], 1u);
        const unsigned gen = old / nloc;
        if (old + 1u == (gen + 1u) * nloc) {
            __builtin_amdgcn_fence(__ATOMIC_RELEASE, "agent");
            asm volatile("s_waitcnt vmcnt(0)" ::: "memory");
            const unsigned og = xb_add(&bar[XB_TOP], 1u);
            const unsigned tg = og / nx;
            if (og + 1u == (tg + 1u) * nx) xb_add(&bar[XB_TOPGEN], 1u);
            else XB_SPIN(xb_ld(&bar[XB_TOPGEN]) == tg, bar);
            __builtin_amdgcn_fence(__ATOMIC_ACQUIRE, "agent");
            xb_add(&bar[XB_XGEN(b.x)], 1u);
            asm volatile("s_waitcnt vmcnt(0)" ::: "memory");
        } else {
            XB_SPIN(xb_ld(&bar[XB_XGEN(b.x)]) == gen, bar);
            __builtin_amdgcn_fence(__ATOMIC_ACQUIRE, "agent");
            asm volatile("s_waitcnt vmcnt(0)" ::: "memory");
        }
    }
    __syncthreads();
}

namespace pg8 {
constexpr int BM = 256, BK = 64, HALF = 128, HTB = HALF * BK * 2, STAGE_BYTES = 8 * HTB, NXCD = 8, WGM = 8;
__host__ __device__ __forceinline__ int lds_byte(int r, int c) { const int st = (r >> 4) * 2 + (c >> 5), rr = r & 15, cc = c & 31, ob = rr * 64 + cc * 2; return st * 1024 + (ob ^ (((ob >> 9) & 1) << 5)); }
__host__ __device__ __forceinline__ void stage_rc(int b, int& R, int& C) { const int st = b / 1024, sb = b % 1024, swz = sb ^ (((sb >> 9) & 1) << 5); R = (st >> 1) * 16 + swz / 64; C = (st & 1) * 32 + (swz % 64) / 2; }
__host__ __device__ __forceinline__ int perm32(int rho) { const int n = rho >> 4, i = rho & 15; return 8 * (i >> 2) + 4 * n + (i & 3); }
struct Unit { int pm, pn; };
struct Gemm { const bf16_t* A; const bf16_t* Bt; int M, N, K; };
struct StaticOrder {
    int nM, nN, nwg, G, c;
    __host__ __device__ void init(int M, int N, int G_, int c_) { nM = M / BM; nN = N / BM; nwg = nM * nN; G = G_; c = c_; }
    __host__ __device__ bool next(int i, Unit& u) const {
        const long L = (long)i * G + c; if (L >= nwg) return false;
        int wgid = (int)L; { const int q = nwg / NXCD, r = nwg % NXCD, xcd = wgid % NXCD, off = wgid / NXCD; wgid = (xcd < r ? xcd * (q + 1) : r * (q + 1) + (xcd - r) * q) + off; }
        const int nig = WGM * nN, gid = wgid / nig, fm = gid * WGM, gsz = (nM - fm) < WGM ? (nM - fm) : WGM;
        u.pm = fm + ((wgid % nig) % gsz); u.pn = (wgid % nig) / gsz; return true;
    }
    __device__ __forceinline__ void a_ready(const Unit&) const {}
    __device__ __forceinline__ void done(const Unit&) const {}
};
__device__ __forceinline__ unsigned cvt_pk_bf16(float lo, float hi) { unsigned r; asm volatile("v_cvt_pk_bf16_f32 %0, %1, %2" : "=v"(r) : "v"(lo), "v"(hi)); return r; }
__device__ __forceinline__ f32x2 gelu_pk(f32x2 v) {
    const f32x2 av = __builtin_elementwise_abs(v), d = av * 0.2316418882f + 1.0f;
    f32x2 t; t.x = __builtin_amdgcn_rcpf(d.x); t.y = __builtin_amdgcn_rcpf(d.y);
    f32x2 q = t * 0.5307027145f + (-0.7265760135f); q = q * t + 0.7107068705f; q = q * t + (-0.142248368f); q = q * t + 0.127414796f; q = q * t;
    const f32x2 s = (v * v) * (-0.72134752044f);
    f32x2 e; e.x = __builtin_amdgcn_exp2f(s.x); e.y = __builtin_amdgcn_exp2f(s.y);
    const f32x2 m = v * (q * e), r = v - m;
    f32x2 o; o.x = v.x < 0.f ? m.x : r.x; o.y = v.y < 0.f ? m.y : r.y; return o;
}
__device__ __forceinline__ float silu_f(float g) { return g * __builtin_amdgcn_rcpf(1.0f + __builtin_amdgcn_exp2f(-1.4426950408889634f * g)); }

struct EpiProj {
    static constexpr bool PERM = true, AFTER_DRAIN = false;
    bf16_t* O; int ldc; int gelu_tiles;
    __device__ __forceinline__ void operator()(const f32x4 (&acc)[2][2][4][2], const Unit& u, int wr, int wc, int fr, int fq) const {
        const int row0 = u.pm * BM + wr * 64 + fr, col0 = u.pn * BM + wc * 32 + 8 * fq; const bool g = u.pn < gelu_tiles;
#pragma unroll
        for (int ai = 0; ai < 2; ++ai)
#pragma unroll
            for (int m = 0; m < 4; ++m) { bf16_t* rowp = O + (size_t)(row0 + ai * HALF + m * 16) * ldc + col0;
#pragma unroll
                for (int bj = 0; bj < 2; ++bj) { f32x4 v0 = acc[ai][bj][m][0], v1 = acc[ai][bj][m][1];
                    if (g) { f32x2 a = gelu_pk((f32x2){v0[0], v0[1]}), b = gelu_pk((f32x2){v0[2], v0[3]}), c = gelu_pk((f32x2){v1[0], v1[1]}), d = gelu_pk((f32x2){v1[2], v1[3]});
                        v0 = (f32x4){a.x, a.y, b.x, b.y}; v1 = (f32x4){c.x, c.y, d.x, d.y}; }
                    u32x4 w; w.x = cvt_pk_bf16(v0[0], v0[1]); w.y = cvt_pk_bf16(v0[2], v0[3]); w.z = cvt_pk_bf16(v1[0], v1[1]); w.w = cvt_pk_bf16(v1[2], v1[3]);
                    *(u32x4*)(rowp + bj * HALF) = w; } }
    }
};
struct EpiSwiglu {
    static constexpr bool PERM = true, AFTER_DRAIN = false;
    bf16_t* O; int ldc;
    __device__ __forceinline__ void operator()(const f32x4 (&acc)[2][2][4][2], const Unit& u, int wr, int wc, int fr, int fq) const {
        const int row0 = u.pm * BM + wr * 64 + fr, col0 = u.pn * HALF + wc * 32 + 8 * fq;
#pragma unroll
        for (int ai = 0; ai < 2; ++ai)
#pragma unroll
            for (int m = 0; m < 4; ++m) { bf16_t* rowp = O + (size_t)(row0 + ai * HALF + m * 16) * ldc + col0;
                const f32x4 g0 = acc[ai][0][m][0], g1 = acc[ai][0][m][1], u0 = acc[ai][1][m][0], u1 = acc[ai][1][m][1];
                u32x4 w; w.x = cvt_pk_bf16(silu_f(g0[0]) * u0[0], silu_f(g0[1]) * u0[1]); w.y = cvt_pk_bf16(silu_f(g0[2]) * u0[2], silu_f(g0[3]) * u0[3]);
                w.z = cvt_pk_bf16(silu_f(g1[0]) * u1[0], silu_f(g1[1]) * u1[1]); w.w = cvt_pk_bf16(silu_f(g1[2]) * u1[2], silu_f(g1[3]) * u1[3]);
                *(u32x4*)rowp = w; }
    }
};
template <bool FROM_X> struct EpiRes {
    static constexpr bool PERM = false, AFTER_DRAIN = false;
    const float* base; const float* stat; const float* gvec; float* out;
    __device__ __forceinline__ void operator()(const f32x4 (&acc)[2][2][4][2], const Unit& u, int wr, int wc, int fr, int fq) const {
        const int row0 = u.pm * BM + wr * 64 + fr, col0 = u.pn * BM + wc * 32 + 4 * fq;
        f32x4 gv[2][2];
#pragma unroll
        for (int bj = 0; bj < 2; ++bj)
#pragma unroll
            for (int n = 0; n < 2; ++n) gv[bj][n] = *(const f32x4*)(gvec + col0 + bj * HALF + n * 16);
#pragma unroll
        for (int ai = 0; ai < 2; ++ai)
#pragma unroll
            for (int m = 0; m < 4; ++m) { const int row = row0 + ai * HALF + m * 16; float mean = 0.f, rstd = 1.f;
                if (FROM_X) { const f32x2 s = *(const f32x2*)(stat + 2 * row); mean = s.x; rstd = s.y; }
                const size_t off = (size_t)row * DM + col0;
#pragma unroll
                for (int bj = 0; bj < 2; ++bj)
#pragma unroll
                    for (int n = 0; n < 2; ++n) { f32x4 b = *(const f32x4*)(base + off + bj * HALF + n * 16); if (FROM_X) b = (b - mean) * rstd;
                        *(f32x4*)(out + off + bj * HALF + n * 16) = b * DN_ALPHA + gv[bj][n] * acc[ai][bj][m][n]; }
                asm volatile("" ::: "memory"); }
    }
};

template <class Epi, class Sched, bool ALIGN_EPI = false, bool SP2 = false>
__device__ __forceinline__ void gemm_phase(LAS unsigned char* lds, const Gemm g, const Sched& S, const Epi& E) {
    const int tid = threadIdx.x, wid = __builtin_amdgcn_readfirstlane(tid >> 6), lane = tid & 63, wr = wid >> 2, wc = wid & 3, fr = lane & 15, fq = lane >> 4;
    const int K = g.K, nt = K / BK;
    unsigned voffA[2], voffB[2];
#pragma unroll
    for (int i = 0; i < 2; ++i) { int R, C; stage_rc(tid * 16 + i * 8192, R, C); const int Rb = Epi::PERM ? ((R & ~31) + perm32(R & 31)) : R;
        voffA[i] = (unsigned)(R * K + C) * 2u; voffB[i] = (unsigned)(Rb * K + C) * 2u; }
    const size_t kstep = (size_t)(BK * 2);
    const size_t hstep = (size_t)HALF * K * 2;
    const size_t tstep = 2 * hstep;
    const unsigned ldsw = (unsigned)wid * 1024u;
    const int aoff = lds_byte(wr * 64 + fr, fq * 8), boff = lds_byte(wc * 32 + fr, fq * 8);
#define PG8_SA(b, h) (((b) * 2 + (h)) * HTB)
#define PG8_SB(b, h) ((4 + (b) * 2 + (h)) * HTB)
#define PG8_STAGE(bufoff, gbase, voff) do { _Pragma("unroll") for (int _i = 0; _i < 2; ++_i) \
        __builtin_amdgcn_global_load_lds((const unsigned*)((const char*)(gbase) + (voff)[_i]), (LAS unsigned*)(lds + (bufoff) + ldsw + _i * 8192), 16, 0, 0); } while (0)
#define PG8_LDA(dst, b, h) do { _Pragma("unroll") for (int m = 0; m < 4; ++m) _Pragma("unroll") for (int k = 0; k < 2; ++k) dst[m][k] = *(const LAS bf16x8*)(lds + PG8_SA(b, h) + aoff + m * 2048 + k * 1024); } while (0)
#define PG8_LDB(dst, b, h) do { _Pragma("unroll") for (int n = 0; n < 2; ++n) _Pragma("unroll") for (int k = 0; k < 2; ++k) dst[n][k] = *(const LAS bf16x8*)(lds + PG8_SB(b, h) + boff + n * 2048 + k * 1024); } while (0)
#define PG8_MMA(ai, bj, At, Bt) do { __builtin_amdgcn_s_setprio(1); _Pragma("unroll") for (int m = 0; m < 4; ++m) _Pragma("unroll") for (int n = 0; n < 2; ++n) _Pragma("unroll") for (int k = 0; k < 2; ++k) \
        acc[ai][bj][m][n] = __builtin_amdgcn_mfma_f32_16x16x32_bf16(Bt[n][k], At[m][k], acc[ai][bj][m][n], 0, 0, 0); __builtin_amdgcn_s_setprio(0); } while (0)
#define PG8_WAIT_V(n) asm volatile("s_waitcnt vmcnt(" #n ")" ::: "memory")
#define PG8_WAIT_L(n) asm volatile("s_waitcnt lgkmcnt(" #n ")" ::: "memory")
#define PG8_BAR __builtin_amdgcn_s_barrier()
#define PG8_SCHED __builtin_amdgcn_sched_barrier(0)
    Unit cur, nxt; int ui = 0;
    if (!S.next(0, cur)) return;
    f32x4 acc[2][2][4][2];
#pragma unroll
    for (int a = 0; a < 2; ++a)
#pragma unroll
        for (int b = 0; b < 2; ++b)
#pragma unroll
            for (int m = 0; m < 4; ++m)
#pragma unroll
                for (int n = 0; n < 2; ++n) acc[a][b][m][n] = (f32x4){0.f, 0.f, 0.f, 0.f};
    bf16x8 At[4][2], B0[2][2], B1[2][2];
    const char* cA = (const char*)g.A + (size_t)cur.pm * tstep; const char* cB = (const char*)g.Bt + (size_t)cur.pn * tstep;
    S.a_ready(cur);
    if constexpr (SP2) {
        PG8_STAGE(PG8_SB(0, 0), cB, voffB); PG8_STAGE(PG8_SB(0, 1), cB + hstep, voffB); PG8_STAGE(PG8_SA(0, 0), cA, voffA); PG8_STAGE(PG8_SA(0, 1), cA + hstep, voffA);
        if (wr == 1) PG8_BAR;
        PG8_WAIT_V(2); PG8_BAR;
        PG8_STAGE(PG8_SB(1, 0), cB + kstep, voffB); PG8_STAGE(PG8_SA(1, 0), cA + kstep, voffA); PG8_STAGE(PG8_SB(1, 1), cB + hstep + kstep, voffB);
        PG8_WAIT_V(6); PG8_BAR;
    } else {
        PG8_STAGE(PG8_SB(0, 0), cB, voffB); PG8_STAGE(PG8_SA(0, 0), cA, voffA); PG8_STAGE(PG8_SB(0, 1), cB + hstep, voffB); PG8_STAGE(PG8_SA(0, 1), cA + hstep, voffA);
        if (wr == 1) PG8_BAR;
        PG8_WAIT_V(4); PG8_BAR;
        PG8_STAGE(PG8_SB(1, 0), cB + kstep, voffB); PG8_STAGE(PG8_SA(1, 0), cA + kstep, voffA); PG8_STAGE(PG8_SB(1, 1), cB + hstep + kstep, voffB);
        PG8_WAIT_V(6); PG8_BAR;
    }
    for (;;) {
        const bool has_next = S.next(ui + 1, nxt);
        const char* nA = has_next ? (const char*)g.A + (size_t)nxt.pm * tstep : cA; const char* nB = has_next ? (const char*)g.Bt + (size_t)nxt.pn * tstep : cB;
        for (int t = 0; t < nt; t += 2) {
            const bool last = (t == nt - 2);
            const char* a1 = cA + (size_t)(t + 1) * kstep;
            const char* a2 = last ? nA : cA + (size_t)(t + 2) * kstep; const char* b2 = last ? nB : cB + (size_t)(t + 2) * kstep;
            const char* a3 = a2 + kstep; const char* b3 = b2 + kstep;
            if (last && has_next) S.a_ready(nxt);
            if constexpr (SP2) {
            PG8_LDB(B0, 0, 0); PG8_LDB(B1, 0, 1); PG8_SCHED; PG8_LDA(At, 0, 0); PG8_STAGE(PG8_SA(1, 1), a1 + hstep, voffA);
            PG8_WAIT_V(8); PG8_WAIT_L(0); PG8_BAR; PG8_MMA(0, 0, At, B0); PG8_MMA(0, 1, At, B1); PG8_BAR; PG8_SCHED;
            PG8_LDA(At, 0, 1); PG8_STAGE(PG8_SB(0, 0), b2, voffB); PG8_STAGE(PG8_SB(0, 1), b2 + hstep, voffB); PG8_STAGE(PG8_SA(0, 0), a2, voffA);
            PG8_WAIT_V(8); PG8_WAIT_L(0); PG8_BAR; PG8_MMA(1, 0, At, B0); PG8_MMA(1, 1, At, B1); PG8_BAR; PG8_SCHED;
            PG8_LDB(B0, 1, 0); PG8_LDB(B1, 1, 1); PG8_SCHED; PG8_LDA(At, 1, 0); PG8_STAGE(PG8_SA(0, 1), a2 + hstep, voffA);
            PG8_WAIT_V(8); PG8_WAIT_L(0); PG8_BAR; PG8_MMA(0, 0, At, B0); PG8_MMA(0, 1, At, B1); PG8_BAR; PG8_SCHED;
            PG8_LDA(At, 1, 1); PG8_STAGE(PG8_SB(1, 0), b3, voffB); PG8_STAGE(PG8_SB(1, 1), b3 + hstep, voffB); PG8_STAGE(PG8_SA(1, 0), a3, voffA);
            PG8_WAIT_V(8); PG8_WAIT_L(0); PG8_BAR; PG8_MMA(1, 0, At, B0); PG8_MMA(1, 1, At, B1); PG8_BAR; PG8_SCHED;
            } else {
            PG8_LDB(B0, 0, 0); PG8_SCHED; PG8_LDA(At, 0, 0); PG8_STAGE(PG8_SA(1, 1), a1 + hstep, voffA);
            PG8_WAIT_L(8); PG8_BAR; PG8_WAIT_L(0); PG8_MMA(0, 0, At, B0); PG8_BAR; PG8_SCHED;
            PG8_LDB(B1, 0, 1); PG8_STAGE(PG8_SB(0, 0), b2, voffB);
            PG8_BAR; PG8_WAIT_L(0); PG8_MMA(0, 1, At, B1); PG8_BAR;
            PG8_LDA(At, 0, 1); PG8_STAGE(PG8_SA(0, 0), a2, voffA);
            PG8_BAR; PG8_WAIT_L(0); PG8_MMA(1, 0, At, B0); PG8_BAR; PG8_SCHED;
            PG8_STAGE(PG8_SB(0, 1), b2 + hstep, voffB);
            PG8_WAIT_V(6); PG8_BAR; PG8_MMA(1, 1, At, B1); PG8_BAR;
            PG8_LDB(B0, 1, 0); PG8_SCHED; PG8_LDA(At, 1, 0); PG8_STAGE(PG8_SA(0, 1), a2 + hstep, voffA);
            PG8_WAIT_L(8); PG8_BAR; PG8_WAIT_L(0); PG8_MMA(0, 0, At, B0); PG8_BAR; PG8_SCHED;
            PG8_LDB(B1, 1, 1); PG8_STAGE(PG8_SB(1, 0), b3, voffB);
            PG8_BAR; PG8_WAIT_L(0); PG8_MMA(0, 1, At, B1); PG8_BAR;
            PG8_LDA(At, 1, 1); PG8_STAGE(PG8_SA(1, 0), a3, voffA);
            PG8_BAR; PG8_WAIT_L(0); PG8_MMA(1, 0, At, B0); PG8_BAR; PG8_SCHED;
            PG8_STAGE(PG8_SB(1, 1), b3 + hstep, voffB);
            PG8_WAIT_V(6); PG8_BAR; PG8_MMA(1, 1, At, B1); PG8_BAR;
            }
        }
        if constexpr (ALIGN_EPI) { if (wr == 0) PG8_BAR; }
        if constexpr (!Epi::AFTER_DRAIN) { E(acc, cur, wr, wc, fr, fq); S.done(cur); }
        if (!has_next) break;
#pragma unroll
        for (int a = 0; a < 2; ++a)
#pragma unroll
            for (int b = 0; b < 2; ++b)
#pragma unroll
                for (int m = 0; m < 4; ++m)
#pragma unroll
                    for (int n = 0; n < 2; ++n) acc[a][b][m][n] = (f32x4){0.f, 0.f, 0.f, 0.f};
        cur = nxt; cA = nA; cB = nB; ++ui;
        if constexpr (ALIGN_EPI) { if (wr == 1) PG8_BAR; }
    }
    PG8_WAIT_V(0);
    if constexpr (!ALIGN_EPI) { if (wr == 0) PG8_BAR; }
    PG8_BAR;
#undef PG8_SA
#undef PG8_SB
#undef PG8_STAGE
#undef PG8_LDA
#undef PG8_LDB
#undef PG8_MMA
#undef PG8_WAIT_V
#undef PG8_WAIT_L
#undef PG8_BAR
#undef PG8_SCHED
}
}

struct Frame {
    LAS unsigned char* lds;
    int tid, lane, wave, bid, G;
    const float *x, *c, *ctx, *c_ctx, *w_ada, *b_ada, *w_in, *w_s, *b_s, *sgu_g, *sgu_b, *rpb, *gn_g, *w_o, *ln_g, *ln_b, *w_gate, *w_up, *w_down;
    float* out;
    float *MOD, *CMOD, *XSTAT, *Z;
    bf16_t *WinT, *WoT, *WguT, *WdT, *H, *HC, *KVC, *P, *OA, *OB, *AWO, *ACT;
};

template <int MODE>
__device__ __forceinline__ void transpose_item(const float* W, int K, int N, bf16_t* WT, int row_off, LAS float* scr, int item, int lane) {
    const int nblk = N / 32, kb = item / nblk, nb = item % nblk, k0 = 64 * kb, n0 = 32 * nb;
#pragma unroll 8
    for (int i = 0; i < 32; ++i) { const int kk = 2 * i + (lane >> 5); scr[kk * 33 + (lane & 31)] = W[(size_t)(k0 + kk) * N + n0 + (lane & 31)]; }
    LDS_WAIT(); asm volatile("" ::: "memory");
    const int c = lane & 7;
#pragma unroll
    for (int j = 0; j < 4; ++j) { const int n = (lane >> 3) + 8 * j; const LAS float* s = scr + (8 * c) * 33 + n;
        u32x4 o; o.x = pk2(s[0 * 33], s[1 * 33]); o.y = pk2(s[2 * 33], s[3 * 33]); o.z = pk2(s[4 * 33], s[5 * 33]); o.w = pk2(s[6 * 33], s[7 * 33]);
        const int nn = n0 + n; const int orow = MODE == 1 ? ((nn >> 7) * 256 + (nn & 127) + row_off) : (nn + row_off);
        *(GAS u32x4*)(WT + (size_t)orow * K + k0 + 8 * c) = o; }
    LDS_WAIT(); asm volatile("" ::: "memory");
}

__device__ __forceinline__ void phase0(Frame& F) {
    {
        LAS float* sc = (LAS float*)F.lds;
        LAS float* sx = sc + 4096;
        LAS float* red = sx + 4096;
        for (int i = F.tid; i < DM; i += 512) { const float a = F.c[i], b = F.c_ctx[i]; sc[i] = a / (1.0f + expf(-a)); sx[i] = b / (1.0f + expf(-b)); }
        __syncthreads();
        for (int u = F.bid; u < 256; u += F.G) {
            const int col0 = u * 96;
            if (F.tid < 384) {
                const int cg = F.tid % 24, kl = F.tid / 24, col = col0 + 4 * cg; const bool doctx = col < 2 * DM;
                f32x4 a = {0.f, 0.f, 0.f, 0.f}, b = {0.f, 0.f, 0.f, 0.f};
                const float* wp = F.w_ada + (size_t)kl * (6 * DM) + col;
                for (int i = 0; i < 256; i += 8) {
                    f32x4 w[8];
#pragma unroll
                    for (int q = 0; q < 8; ++q) w[q] = *(const f32x4*)(wp + (size_t)(i + q) * 16 * (6 * DM));
#pragma unroll
                    for (int q = 0; q < 8; ++q) { const int k = kl + 16 * (i + q); a += w[q] * sc[k]; if (doctx) b += w[q] * sx[k]; }
                }
                *(LAS f32x4*)(red + kl * 192 + 4 * cg) = a; *(LAS f32x4*)(red + kl * 192 + 96 + 4 * cg) = b;
            }
            __syncthreads();
            if (F.tid < 192) {
                float s = 0.f;
#pragma unroll
                for (int kl = 0; kl < 16; ++kl) s += red[kl * 192 + F.tid];
                const int cc = col0 + (F.tid < 96 ? F.tid : F.tid - 96);
                if (F.tid < 96) F.MOD[cc] = s + F.b_ada[cc];
                else if (cc < 2 * DM) F.CMOD[cc] = s + F.b_ada[cc];
            }
            __syncthreads();
        }
    }
    {
        LAS float* scr = (LAS float*)(F.lds + F.wave * 16384);
        const int gw = F.bid * 8 + F.wave, NGW = F.G * 8;
        constexpr int I_IN = (DM / 64) * (NIN / 32), I_O = (DM / 64) * (DM / 32), I_G = (DM / 64) * (DFF / 32), I_D = (DFF / 64) * (DM / 32);
        constexpr int NITEMS = I_IN + I_O + 2 * I_G + I_D;
        for (int it = gw; it < NITEMS; it += NGW) {
            int r = it;
            if (r < I_IN) { transpose_item<0>(F.w_in, DM, NIN, F.WinT, 0, scr, r, F.lane); continue; } r -= I_IN;
            if (r < I_O) { transpose_item<0>(F.w_o, DM, DM, F.WoT, 0, scr, r, F.lane); continue; } r -= I_O;
            if (r < I_G) { transpose_item<1>(F.w_gate, DM, DFF, F.WguT, 0, scr, r, F.lane); continue; } r -= I_G;
            if (r < I_G) { transpose_item<1>(F.w_up, DM, DFF, F.WguT, 128, scr, r, F.lane); continue; } r -= I_G;
            transpose_item<0>(F.w_down, DFF, DM, F.WdT, 0, scr, r, F.lane);
        }
    }
}

__device__ __forceinline__ void ln_rows_p1(Frame& F) {
    LAS float* sh = (LAS float*)F.lds;
    LAS float* sc = sh + DM;
    LAS float* csh = sc + DM;
    LAS float* csc = csh + DM;
    for (int i = F.tid; i < DM; i += 512) { sh[i] = F.MOD[i]; sc[i] = 1.0f + F.MOD[DM + i]; csh[i] = F.CMOD[i]; csc[i] = 1.0f + F.CMOD[DM + i]; }
    __syncthreads();
    const int gw = F.bid * 8 + F.wave, NGW = F.G * 8;
    for (int m = gw; m < SEQ + CTXL; m += NGW) {
        const bool isx = m < SEQ;
        const float* src = isx ? F.x + (size_t)m * DM : F.ctx + (size_t)(m - SEQ) * DM;
        bf16_t* dst = isx ? F.H + (size_t)m * DM : F.HC + (size_t)(m - SEQ) * DM;
        const LAS float* shp = isx ? sh : csh; const LAS float* scp = isx ? sc : csc;
        const f32x4* xr = (const f32x4*)src + F.lane;
        f32x4 v[16]; float s = 0.f;
#pragma unroll
        for (int j = 0; j < 16; ++j) { v[j] = xr[64 * j]; s += (v[j].x + v[j].y) + (v[j].z + v[j].w); }
        const float mean = wave_sum(s) * (1.f / DM); float s2 = 0.f;
#pragma unroll
        for (int j = 0; j < 16; ++j) { v[j] = v[j] - mean; s2 += (v[j].x * v[j].x + v[j].y * v[j].y) + (v[j].z * v[j].z + v[j].w * v[j].w); }
        const float rstd = 1.f / sqrtf(wave_sum(s2) * (1.f / DM) + LN_EPS);
        if (isx && F.lane == 0) { F.XSTAT[2 * m] = mean; F.XSTAT[2 * m + 1] = rstd; }
        u32x2* o8 = (u32x2*)dst + F.lane;
#pragma unroll
        for (int j = 0; j < 16; ++j) { const int col = 4 * (F.lane + 64 * j); const f32x4 a = *(const LAS f32x4*)(scp + col), b = *(const LAS f32x4*)(shp + col);
            const f32x4 h = v[j] * rstd * a + b; u32x2 w; w.x = pk2(h.x, h.y); w.y = pk2(h.z, h.w); o8[64 * j] = w; asm volatile("" ::: "memory"); }
    }
}
__device__ __forceinline__ void ln_rows_p6(Frame& F) {
    LAS float* lg = (LAS float*)F.lds; LAS float* lb = lg + DM; LAS float* sh = lb + DM; LAS float* sc = sh + DM;
    for (int i = F.tid; i < DM; i += 512) { lg[i] = F.ln_g[i]; lb[i] = F.ln_b[i]; sh[i] = F.MOD[3 * DM + i]; sc[i] = 1.0f + F.MOD[4 * DM + i]; }
    __syncthreads();
    const int gw = F.bid * 8 + F.wave, NGW = F.G * 8;
    for (int m = gw; m < SEQ; m += NGW) {
        f32x4* zr = (f32x4*)(F.Z + (size_t)m * DM) + F.lane;
        f32x4 v[16]; float s = 0.f;
#pragma unroll
        for (int j = 0; j < 16; ++j) { v[j] = zr[64 * j]; s += (v[j].x + v[j].y) + (v[j].z + v[j].w); }
        const float mean = wave_sum(s) * (1.f / DM); float s2 = 0.f;
#pragma unroll
        for (int j = 0; j < 16; ++j) { v[j] = v[j] - mean; s2 += (v[j].x * v[j].x + v[j].y * v[j].y) + (v[j].z * v[j].z + v[j].w * v[j].w); }
        const float rstd = 1.f / sqrtf(wave_sum(s2) * (1.f / DM) + LN_EPS);
        u32x2* o8 = (u32x2*)(F.H + (size_t)m * DM) + F.lane;
#pragma unroll
        for (int j = 0; j < 16; ++j) { const int col = 4 * (F.lane + 64 * j);
            const f32x4 x1 = v[j] * rstd * *(const LAS f32x4*)(lg + col) + *(const LAS f32x4*)(lb + col);
            zr[64 * j] = x1;
            const f32x4 h = x1 * *(const LAS f32x4*)(sc + col) + *(const LAS f32x4*)(sh + col); u32x2 w; w.x = pk2(h.x, h.y); w.y = pk2(h.z, h.w); o8[64 * j] = w;
            asm volatile("" ::: "memory"); }
    }
}
__device__ __forceinline__ void ln_rows_p9(Frame& F) {
    LAS float* lg = (LAS float*)F.lds; LAS float* lb = lg + DM;
    for (int i = F.tid; i < DM; i += 512) { lg[i] = F.ln_g[DM + i]; lb[i] = F.ln_b[DM + i]; }
    __syncthreads();
    const int gw = F.bid * 8 + F.wave, NGW = F.G * 8;
    for (int m = gw; m < SEQ; m += NGW) {
        f32x4* zr = (f32x4*)(F.out + (size_t)m * DM) + F.lane;
        f32x4 v[16]; float s = 0.f;
#pragma unroll
        for (int j = 0; j < 16; ++j) { v[j] = zr[64 * j]; s += (v[j].x + v[j].y) + (v[j].z + v[j].w); }
        const float mean = wave_sum(s) * (1.f / DM); float s2 = 0.f;
#pragma unroll
        for (int j = 0; j < 16; ++j) { v[j] = v[j] - mean; s2 += (v[j].x * v[j].x + v[j].y * v[j].y) + (v[j].z * v[j].z + v[j].w * v[j].w); }
        const float rstd = 1.f / sqrtf(wave_sum(s2) * (1.f / DM) + LN_EPS);
#pragma unroll
        for (int j = 0; j < 16; ++j) { const int col = 4 * (F.lane + 64 * j);
            zr[64 * j] = v[j] * rstd * *(const LAS f32x4*)(lg + col) + *(const LAS f32x4*)(lb + col); asm volatile("" ::: "memory"); }
    }
}
__device__ __forceinline__ void merge_rows(Frame& F) {
    const int gw = F.bid * 8 + F.wave, NGW = F.G * 8;
    for (int m = gw; m < SEQ; m += NGW) {
#pragma unroll
        for (int part = 0; part < 2; ++part) {
            const u32x4* src = (const u32x4*)((part ? F.OB : F.OA) + (size_t)m * WSGU) + F.lane;
            u32x4 w[4]; float f[32]; float s2 = 0.f;
#pragma unroll
            for (int j = 0; j < 4; ++j) w[j] = src[64 * j];
#pragma unroll
            for (int j = 0; j < 4; ++j)
#pragma unroll
                for (int e = 0; e < 4; ++e) { const float a = bflo(w[j][e]), b = bfhi(w[j][e]); f[8 * j + 2 * e] = a; f[8 * j + 2 * e + 1] = b; s2 += a * a + b * b; }
            const float r = 1.f / sqrtf(wave_sum(s2) * (1.f / WSGU) + LN_EPS);
            u32x4* dst = (u32x4*)(F.AWO + (size_t)m * DM + part * WSGU) + F.lane;
#pragma unroll
            for (int j = 0; j < 4; ++j) { const float* gp = F.gn_g + part * WSGU + 8 * (F.lane + 64 * j); const f32x4 g0 = *(const f32x4*)gp, g1 = *(const f32x4*)(gp + 4);
                u32x4 o; o.x = pk2(f[8 * j + 0] * r * g0.x, f[8 * j + 1] * r * g0.y); o.y = pk2(f[8 * j + 2] * r * g0.z, f[8 * j + 3] * r * g0.w);
                o.z = pk2(f[8 * j + 4] * r * g1.x, f[8 * j + 5] * r * g1.y); o.w = pk2(f[8 * j + 6] * r * g1.z, f[8 * j + 7] * r * g1.w);
                dst[64 * j] = o; }
        }
    }
}

__device__ __forceinline__ int crow(int r, int hi) { return (r & 3) + 8 * (r >> 2) + 4 * hi; }
__device__ __forceinline__ void sgu_unit(Frame& F, int n, int hg) {
    const int tid = F.tid, wid = F.wave, lane = F.lane, r = lane & 31, hf = lane >> 5;
    LAS f32x2* stat = (LAS f32x2*)F.lds;
    LAS bf16_t* VT = (LAS bf16_t*)(F.lds + 1024);
    __syncthreads();
    for (int i = 0; i < 16; ++i) {
        const int q = 16 * wid + i;
        const u32x4* rp = (const u32x4*)(F.P + (size_t)(128 * n + q) * NIN + WSGU) + lane;
        u32x4 w[4]; float f[32]; float s = 0.f;
#pragma unroll
        for (int j = 0; j < 4; ++j) w[j] = rp[64 * j];
#pragma unroll
        for (int j = 0; j < 4; ++j)
#pragma unroll
            for (int e = 0; e < 4; ++e) { f[8 * j + 2 * e] = bflo(w[j][e]); f[8 * j + 2 * e + 1] = bfhi(w[j][e]); s += f[8 * j + 2 * e] + f[8 * j + 2 * e + 1]; }
        const float mean = wave_sum(s) * (1.f / WSGU); float s2 = 0.f;
#pragma unroll
        for (int e = 0; e < 32; ++e) { const float d = f[e] - mean; s2 += d * d; }
        const float rstd = 1.f / sqrtf(wave_sum(s2) * (1.f / WSGU) + LN_EPS);
        if (lane == 0) stat[q] = (f32x2){mean, rstd};
    }
    __syncthreads();
    const int pb = wid & 3, dh = wid >> 2, p = 32 * pb + r;
    for (int hh = 0; hh < 4; ++hh) {
        const int h = 4 * hg + hh;
        {
            const int q = tid >> 2, dseg = (tid & 3) * 32;
            const u32x4* sp = (const u32x4*)(F.P + (size_t)(128 * n + q) * NIN + WSGU + 128 * h + dseg);
            u32x4 w[4];
#pragma unroll
            for (int j = 0; j < 4; ++j) w[j] = sp[j];
            const f32x2 st = stat[q];
#pragma unroll
            for (int j = 0; j < 4; ++j)
#pragma unroll
                for (int e = 0; e < 4; ++e) { const int d = dseg + 8 * j + 2 * e;
                    const float g0 = F.sgu_g[128 * h + d], g1 = F.sgu_g[128 * h + d + 1], b0 = F.sgu_b[128 * h + d], b1 = F.sgu_b[128 * h + d + 1];
                    const float a = (bflo(w[j][e]) - st.x) * st.y * g0 + b0, b = (bfhi(w[j][e]) - st.x) * st.y * g1 + b1;
                    VT[d * 136 + q] = (bf16_t)f2bf(a); VT[(d + 1) * 136 + q] = (bf16_t)f2bf(b); }
        }
        bf16x8 wsf[8];
        {
            const float* wp = F.w_s + ((size_t)h * 128 + p) * 128 + 8 * hf;
#pragma unroll
            for (int s = 0; s < 8; ++s) { const f32x4 a = *(const f32x4*)(wp + 16 * s), b = *(const f32x4*)(wp + 16 * s + 4);
                u32x4 w; w.x = pk2(a.x, a.y); w.y = pk2(a.z, a.w); w.z = pk2(b.x, b.y); w.w = pk2(b.z, b.w); wsf[s] = __builtin_bit_cast(bf16x8, w); }
        }
        __syncthreads();
        f32x16 acc[2];
#pragma unroll
        for (int db = 0; db < 2; ++db) {
            acc[db] = (f32x16){0.f, 0.f, 0.f, 0.f, 0.f, 0.f, 0.f, 0.f, 0.f, 0.f, 0.f, 0.f, 0.f, 0.f, 0.f, 0.f};
            const int d0 = 64 * dh + 32 * db;
#pragma unroll
            for (int s = 0; s < 8; ++s) { const bf16x8 a = *(const LAS bf16x8*)(VT + (d0 + r) * 136 + 16 * s + 8 * hf);
                acc[db] = __builtin_amdgcn_mfma_f32_32x32x16_bf16(a, wsf[s], acc[db], 0, 0, 0); }
        }
        const float bsp = F.b_s[h * 128 + p]; const size_t row = (size_t)(128 * n + p);
#pragma unroll
        for (int db = 0; db < 2; ++db)
#pragma unroll
            for (int g = 0; g < 4; ++g) { const int d = 64 * dh + 32 * db + 8 * g + 4 * hf;
                const u32x2 uu = *(const u32x2*)(F.P + row * NIN + 128 * h + d);
                const float o0 = bflo(uu.x) * (acc[db][4 * g + 0] + bsp), o1 = bfhi(uu.x) * (acc[db][4 * g + 1] + bsp), o2 = bflo(uu.y) * (acc[db][4 * g + 2] + bsp), o3 = bfhi(uu.y) * (acc[db][4 * g + 3] + bsp);
                u32x2 w; w.x = pk2(o0, o1); w.y = pk2(o2, o3); *(u32x2*)(F.OA + row * WSGU + 128 * h + d) = w; }
        __syncthreads();
    }
}

namespace na {
constexpr float SCALE = 0.088388347648318440f;
constexpr float C = SCALE * 1.4426950408889634f;
#define KSWZ(row, colB) ((row) * 256 + ((colB) ^ (((row) & 7) << 4)))
#define SBAR() __builtin_amdgcn_sched_barrier(0)
__device__ __forceinline__ unsigned cvtpk(float lo, float hi) { unsigned r; asm volatile("v_cvt_pk_bf16_f32 %0, %1, %2" : "=v"(r) : "v"(lo), "v"(hi)); return r; }
__device__ __forceinline__ void partialSM(f32x16& p0, f32x16& p1, float& m_reg, float& mn, float& alpha) {
    float pmax = p0[0];
#pragma unroll
    for (int r = 1; r < 16; ++r) pmax = fmaxf(pmax, p0[r]);
#pragma unroll
    for (int r = 0; r < 16; ++r) pmax = fmaxf(pmax, p1[r]);
    { auto rr = __builtin_amdgcn_permlane32_swap(__float_as_uint(pmax), __float_as_uint(pmax), false, false);
      pmax = fmaxf(__uint_as_float(rr[0]), __uint_as_float(rr[1])); }
    if (__all(pmax - m_reg <= 0.f)) { mn = m_reg; alpha = 1.f; }
    else { mn = fmaxf(m_reg, pmax); alpha = __builtin_amdgcn_exp2f((m_reg - mn) * C); m_reg = mn; }
    const float mnC = -mn * C;
#pragma unroll
    for (int r = 0; r < 16; ++r) p0[r] = fmaf(p0[r], C, mnC);
#pragma unroll
    for (int r = 0; r < 16; ++r) p1[r] = fmaf(p1[r], C, mnC);
#pragma unroll
    for (int r = 0; r < 16; ++r) p0[r] = __builtin_amdgcn_exp2f(p0[r]);
}
__device__ __forceinline__ void finishSM(f32x16& p0, f32x16& p1, float alpha, float& l_reg, bf16x8& pa0, bf16x8& pa1, bf16x8& pa2, bf16x8& pa3) {
#pragma unroll
    for (int r = 0; r < 16; ++r) p1[r] = __builtin_amdgcn_exp2f(p1[r]);
    float ps = 0;
#pragma unroll
    for (int r = 0; r < 16; ++r) ps += p0[r];
#pragma unroll
    for (int r = 0; r < 16; ++r) ps += p1[r];
    { auto rr = __builtin_amdgcn_permlane32_swap(__float_as_uint(ps), __float_as_uint(ps), false, false);
      ps = __uint_as_float(rr[0]) + __uint_as_float(rr[1]); }
    l_reg = l_reg * alpha + ps;
#define PK4(P, BASE, OUT) do { unsigned a0 = cvtpk(P[BASE + 0], P[BASE + 1]), a1 = cvtpk(P[BASE + 2], P[BASE + 3]);   \
    unsigned b0 = cvtpk(P[BASE + 4], P[BASE + 5]), b1 = cvtpk(P[BASE + 6], P[BASE + 7]);                              \
    auto r0 = __builtin_amdgcn_permlane32_swap(a0, b0, false, false); auto r1 = __builtin_amdgcn_permlane32_swap(a1, b1, false, false); \
    u32x4 w = {r0[0], r1[0], r0[1], r1[1]}; OUT = __builtin_bit_cast(bf16x8, w); } while (0)
    PK4(p0, 0, pa0); PK4(p0, 8, pa1); PK4(p1, 0, pa2); PK4(p1, 8, pa3);
#undef PK4
}
__device__ __forceinline__ void qkt(f32x16& p0, f32x16& p1, const LAS char* Ks, const bf16x8* qr, int r32, int hi) {
    p0 = (f32x16){0.f, 0.f, 0.f, 0.f, 0.f, 0.f, 0.f, 0.f, 0.f, 0.f, 0.f, 0.f, 0.f, 0.f, 0.f, 0.f}; p1 = p0;
#pragma unroll
    for (int d0 = 0; d0 < 8; ++d0) { const int cb = (d0 * 16 + hi * 8) * 2;
        const bf16x8 b0 = *(const LAS bf16x8*)(Ks + KSWZ(r32, cb));
        const bf16x8 b1 = *(const LAS bf16x8*)(Ks + KSWZ(32 + r32, cb));
        p0 = __builtin_amdgcn_mfma_f32_32x32x16_bf16(b0, qr[d0], p0, 0, 0, 0);
        p1 = __builtin_amdgcn_mfma_f32_32x32x16_bf16(b1, qr[d0], p1, 0, 0, 0); }
}
__device__ __forceinline__ int v_st(int k, int c) { const int kk = (k & ~0xC) | ((k & 4) << 1) | ((k & 8) >> 1); return ((kk >> 3) * 4 + (c >> 5)) * 512 + ((kk & 7) * 32 + (c & 31)) * 2; }
__device__ __forceinline__ int v_rd_base(int lane) { return ((lane & 3) << 3) | (((lane >> 2) & 3) << 6) | (((lane >> 4) & 1) << 5) | (((lane >> 5) & 1) << 8); }
constexpr int v_rd_off(int d0, int ks, int half) { return d0 * 512 + ks * 4096 + half * 2048; }
template <int OFF> __device__ __forceinline__ s16x4 tr_read(int vb) {
    s16x4 r; asm volatile("ds_read_b64_tr_b16 %0, %1 offset:%2" : "=&v"(r) : "v"(vb), "i"(OFF) : "memory"); return r;
}
template <int D0> __device__ __forceinline__ void pv_one(f32x16& od, int vb, bf16x8 pa0, bf16x8 pa1, bf16x8 pa2, bf16x8 pa3) {
    const s16x4 l0 = tr_read<v_rd_off(D0, 0, 0)>(vb), h0 = tr_read<v_rd_off(D0, 0, 1)>(vb), l1 = tr_read<v_rd_off(D0, 1, 0)>(vb), h1 = tr_read<v_rd_off(D0, 1, 1)>(vb);
    const s16x4 l2 = tr_read<v_rd_off(D0, 2, 0)>(vb), h2 = tr_read<v_rd_off(D0, 2, 1)>(vb), l3 = tr_read<v_rd_off(D0, 3, 0)>(vb), h3 = tr_read<v_rd_off(D0, 3, 1)>(vb);
    asm volatile("s_waitcnt lgkmcnt(0)" ::: "memory"); SBAR();
#define PK(L, H) (bf16x8){L[0], L[1], L[2], L[3], H[0], H[1], H[2], H[3]}
    od = __builtin_amdgcn_mfma_f32_32x32x16_bf16(pa0, PK(l0, h0), od, 0, 0, 0);
    od = __builtin_amdgcn_mfma_f32_32x32x16_bf16(pa1, PK(l1, h1), od, 0, 0, 0);
    od = __builtin_amdgcn_mfma_f32_32x32x16_bf16(pa2, PK(l2, h2), od, 0, 0, 0);
    od = __builtin_amdgcn_mfma_f32_32x32x16_bf16(pa3, PK(l3, h3), od, 0, 0, 0);
#undef PK
}
__device__ __forceinline__ void pv_d0(f32x16* o, int vb, bf16x8 pa0, bf16x8 pa1, bf16x8 pa2, bf16x8 pa3) {
    pv_one<0>(o[0], vb, pa0, pa1, pa2, pa3); pv_one<1>(o[1], vb, pa0, pa1, pa2, pa3); pv_one<2>(o[2], vb, pa0, pa1, pa2, pa3); pv_one<3>(o[3], vb, pa0, pa1, pa2, pa3);
}
}

__device__ __forceinline__ void na_unit(Frame& F, int rg, int h) {
    using namespace na;
    const int tid = F.tid, wid = F.wave, lane = F.lane, r32 = lane & 31, hi = lane >> 5;
    LAS char* V_lds = (LAS char*)F.lds; LAS char* K_lds = V_lds + 16384;
    LAS float* wsc = (LAS float*)(V_lds + 32768) + wid * 64; LAS float* li_l = wsc; LAS float* al_l = wsc + 32;
    LAS float* tbl = (LAS float*)(V_lds + 34816);
    const int rq = 4 * rg + (wid >> 1), ch = wid & 1;
    const int wstart = min(max(rq - 4, 0), 120);
    const int lo = min(max(4 * rg - 4, 0), 120), hirow = min(max(4 * rg - 1, 0), 120) + 7, nlat = hirow - lo + 1;
    __syncthreads();
    for (int i = tid; i < 15 * 32; i += 512) { const int dr = i >> 5, dc = i & 31; tbl[i] = dc < 31 ? F.rpb[(h * 15 + dr) * 31 + dc] * 11.313708498984761f : 0.f; }
    bf16x8 qr[8];
    { const bf16_t* Qw = F.P + (size_t)(64 * rq + 32 * ch + r32) * NIN + 2 * WSGU + 128 * h + hi * 8;
#pragma unroll
      for (int d0 = 0; d0 < 8; ++d0) qr[d0] = *(const bf16x8*)(Qw + d0 * 16); }
    float m_reg = -1e30f, l_reg = 0.f;
    f32x16 o[4];
#pragma unroll
    for (int d = 0; d < 4; ++d) o[d] = (f32x16){0.f, 0.f, 0.f, 0.f, 0.f, 0.f, 0.f, 0.f, 0.f, 0.f, 0.f, 0.f, 0.f, 0.f, 0.f, 0.f};
    const int sr = tid >> 4, sc = (tid & 15) * 8, vst0 = v_st(sr, sc), vst1 = v_st(32 + sr, sc);
    const int vb0 = (int)(size_t)V_lds + v_rd_base(lane);
    const int qc = 32 * ch + r32, cs = min(max(qc - 8, 0), 48);
    for (int j = 0; j < nlat + 4; ++j) {
        const bool lat = j < nlat; const int kr = lo + j;
        __syncthreads();
        {
            const bf16_t* ks; size_t pitch;
            if (lat) { ks = F.P + (size_t)(64 * kr) * NIN + 3 * WSGU + 128 * h; pitch = NIN; }
            else { ks = F.KVC + (size_t)(64 * (j - nlat)) * DM + 128 * h; pitch = DM; }
            const bf16_t* vs = ks + WSGU;
            const bf16x8 k0 = *(const bf16x8*)(ks + (size_t)sr * pitch + sc), k1 = *(const bf16x8*)(ks + (size_t)(32 + sr) * pitch + sc);
            const bf16x8 v0 = *(const bf16x8*)(vs + (size_t)sr * pitch + sc), v1 = *(const bf16x8*)(vs + (size_t)(32 + sr) * pitch + sc);
            *(LAS bf16x8*)(V_lds + vst0) = v0; *(LAS bf16x8*)(V_lds + vst1) = v1;
            *(LAS bf16x8*)(K_lds + KSWZ(sr, sc * 2)) = k0; *(LAS bf16x8*)(K_lds + KSWZ(32 + sr, sc * 2)) = k1;
        }
        __syncthreads();
        const bool active = lat ? (kr >= wstart && kr < wstart + 8) : true;
        if (active) {
            f32x16 p0, p1; qkt(p0, p1, K_lds, qr, r32, hi);
            if (lat) {
                const int dr32 = (kr - rq + 7) * 32;
#pragma unroll
                for (int r = 0; r < 16; ++r) {
                    const int kc0 = crow(r, hi), kc1 = kc0 + 32;
                    const bool v0 = (unsigned)(kc0 - cs) < 16u, v1 = (unsigned)(kc1 - cs) < 16u;
                    const float b0 = tbl[v0 ? dr32 + (kc0 - qc + 15) : 0], b1 = tbl[v1 ? dr32 + (kc1 - qc + 15) : 0];
                    p0[r] = v0 ? p0[r] + b0 : -1e30f; p1[r] = v1 ? p1[r] + b1 : -1e30f;
                }
            }
            float mn, alpha; partialSM(p0, p1, m_reg, mn, alpha);
            if (__any(alpha < 1.f)) { if (hi == 0) al_l[r32] = alpha; LDS_WAIT();
#pragma unroll
                for (int d = 0; d < 4; ++d)
#pragma unroll
                    for (int r = 0; r < 16; ++r) o[d][r] *= al_l[crow(r, hi)]; }
            bf16x8 pa0, pa1, pa2, pa3; finishSM(p0, p1, alpha, l_reg, pa0, pa1, pa2, pa3); SBAR();
            pv_d0(o, vb0, pa0, pa1, pa2, pa3);
        }
    }
    if (hi == 0) li_l[r32] = l_reg; LDS_WAIT();
    float rli[16];
#pragma unroll
    for (int r = 0; r < 16; ++r) rli[r] = 1.0f / li_l[crow(r, hi)];
    bf16_t* Ow = F.OB + (size_t)(64 * rq + 32 * ch) * WSGU + 128 * h;
#pragma unroll
    for (int r = 0; r < 16; ++r) { const int orow = crow(r, hi);
#pragma unroll
        for (int d0 = 0; d0 < 4; ++d0) Ow[(size_t)orow * WSGU + d0 * 32 + r32] = (bf16_t)f2bf(o[d0][r] * rli[r]); }
}

struct Args { const float* in[19]; float* out; unsigned char* ws; int ph_lo, ph_hi; };
__global__ void __launch_bounds__(512, 2) fwd(Args args) {
    extern __shared__ __attribute__((aligned(16))) unsigned char lds_raw[];
    Frame F;
    F.lds = (LAS unsigned char*)lds_raw;
    F.tid = threadIdx.x; F.lane = F.tid & 63; F.wave = __builtin_amdgcn_readfirstlane(F.tid >> 6); F.bid = blockIdx.x; F.G = gridDim.x;
    unsigned char* ws = args.ws;
    F.x = args.in[0]; F.c = args.in[1]; F.ctx = args.in[2]; F.c_ctx = args.in[3]; F.w_ada = args.in[4]; F.b_ada = args.in[5]; F.w_in = args.in[6]; F.w_s = args.in[7]; F.b_s = args.in[8];
    F.sgu_g = args.in[9]; F.sgu_b = args.in[10]; F.rpb = args.in[11]; F.gn_g = args.in[12]; F.w_o = args.in[13]; F.ln_g = args.in[14]; F.ln_b = args.in[15]; F.w_gate = args.in[16]; F.w_up = args.in[17]; F.w_down = args.in[18];
    F.out = args.out;
    F.MOD = (float*)(ws + WS_MOD); F.CMOD = (float*)(ws + WS_CMOD); F.XSTAT = (float*)(ws + WS_XSTAT); F.Z = (float*)(ws + WS_Z);
    F.WinT = (bf16_t*)(ws + WS_WIN); F.WoT = (bf16_t*)(ws + WS_WO); F.WguT = (bf16_t*)(ws + WS_WGU); F.WdT = (bf16_t*)(ws + WS_WD);
    F.H = (bf16_t*)(ws + WS_H); F.HC = (bf16_t*)(ws + WS_HC); F.KVC = (bf16_t*)(ws + WS_KVC); F.P = (bf16_t*)(ws + WS_P);
    F.OA = (bf16_t*)(ws + WS_OA); F.OB = (bf16_t*)(ws + WS_OB); F.AWO = (bf16_t*)(ws + WS_AWO); F.ACT = (bf16_t*)(ws + WS_ACT);
    volatile LAS unsigned* MISC = (volatile LAS unsigned*)(F.lds + MISC_OFF);
    if (F.tid < 32) MISC[F.tid] = 0u;
    __syncthreads();
    const int lo = args.ph_lo, hi = args.ph_hi;
    XcdBarrier bar; bar.bar = (unsigned*)(ws + WS_CTL) + CW_BAR; bar.x = 0; bar.st = nullptr;
    if (hi - lo > 1) bar = xcd_barrier_post((unsigned*)(ws + WS_CTL) + CW_BAR, MISC + 8);
#define IN(k) (lo <= (k) && (k) < hi)
#define SEAM(k) do { if (IN(k) && IN((k) + 1)) xcd_barrier(bar); } while (0)

    if (IN(0)) { phase0(F); } SEAM(0);
    if (IN(1)) { ln_rows_p1(F); } SEAM(1);
    if (IN(2)) {
        { pg8::Gemm g{F.H, F.WinT, SEQ, NIN, DM}; pg8::StaticOrder S; S.init(SEQ, NIN, F.G, F.bid); pg8::EpiProj E{F.P, NIN, 16};
          pg8::gemm_phase<pg8::EpiProj, pg8::StaticOrder, true, true>(F.lds, g, S, E); }
        { pg8::Gemm g{F.HC, F.WinT + (size_t)(3 * WSGU) * DM, CTXL, 2 * WSGU, DM}; pg8::StaticOrder S; S.init(CTXL, 2 * WSGU, F.G, F.bid); pg8::EpiProj E{F.KVC, DM, 0};
          pg8::gemm_phase<pg8::EpiProj, pg8::StaticOrder, true, true>(F.lds, g, S, E); }
    } SEAM(2);
    if (IN(3)) {
        for (int u = F.bid; u < 256; u += F.G) sgu_unit(F, u >> 2, u & 3);
        for (int u = F.bid; u < 512; u += F.G) na_unit(F, u >> 4, u & 15);
    } SEAM(3);
    if (IN(4)) { merge_rows(F); } SEAM(4);
    if (IN(5)) { pg8::Gemm g{F.AWO, F.WoT, SEQ, DM, DM}; pg8::StaticOrder S; S.init(SEQ, DM, F.G, F.bid); pg8::EpiRes<true> E{F.x, F.XSTAT, F.MOD + 2 * DM, F.Z};
        pg8::gemm_phase<pg8::EpiRes<true>, pg8::StaticOrder, true, true>(F.lds, g, S, E); } SEAM(5);
    if (IN(6)) { ln_rows_p6(F); } SEAM(6);
    if (IN(7)) { pg8::Gemm g{F.H, F.WguT, SEQ, NGU, DM}; pg8::StaticOrder S; S.init(SEQ, NGU, F.G, F.bid); pg8::EpiSwiglu E{F.ACT, DFF};
        pg8::gemm_phase<pg8::EpiSwiglu, pg8::StaticOrder, true, true>(F.lds, g, S, E); } SEAM(7);
    if (IN(8)) { pg8::Gemm g{F.ACT, F.WdT, SEQ, DM, DFF}; pg8::StaticOrder S; S.init(SEQ, DM, F.G, F.bid); pg8::EpiRes<false> E{F.Z, nullptr, F.MOD + 5 * DM, F.out};
        pg8::gemm_phase<pg8::EpiRes<false>, pg8::StaticOrder, true, true>(F.lds, g, S, E); } SEAM(8);
    if (IN(9)) { ln_rows_p9(F); }
#undef IN
#undef SEAM
}

extern "C" void kernel_launch(void* const* d_in, const int* in_sizes, int n_in, void* d_out, int out_size, void* d_ws, size_t ws_size, hipStream_t stream) {
    static int grid = 0;
    if (grid == 0) {
        if (n_in != 19 || out_size != SEQ * DM || ws_size < WS_END) { fprintf(stderr, "kernel_launch: unexpected shapes (n_in %d out %d ws %zu)\n", n_in, out_size, ws_size); grid = -1; return; }
        int dev = 0, cus = 0;
        if (hipGetDevice(&dev) != hipSuccess || hipDeviceGetAttribute(&cus, hipDeviceAttributeMultiprocessorCount, dev) != hipSuccess) { grid = -1; return; }
        if (hipFuncSetAttribute((const void*)fwd, hipFuncAttributeMaxDynamicSharedMemorySize, LDS_BYTES) != hipSuccess) { fprintf(stderr, "kernel_launch: hipFuncSetAttribute failed\n"); grid = -1; return; }
        int per_cu = 0;
        if (hipOccupancyMaxActiveBlocksPerMultiprocessor(&per_cu, (const void*)fwd, 512, LDS_BYTES) != hipSuccess || per_cu < 1) fprintf(stderr, "kernel_launch: occupancy query says %d\n", per_cu);
        (void)hipGetLastError();
        grid = cus;
    }
    if (grid < 0) return;
    (void)hipMemsetAsync((char*)d_ws + WS_CTL, 0, CTL_ZERO_BYTES, stream);
    Args a{};
    for (int i = 0; i < 19; ++i) a.in[i] = (const float*)d_in[i];
    a.out = (float*)d_out; a.ws = (unsigned char*)d_ws;
    constexpr int NL = MK_N_LAUNCHES;
    if (NL == 1) { a.ph_lo = 0; a.ph_hi = NPHASE; hipLaunchKernelGGL(fwd, dim3(grid), dim3(512), LDS_BYTES, stream, a); }
    else { for (int p = 0; p < NPHASE; ++p) { a.ph_lo = p; a.ph_hi = p + 1; hipLaunchKernelGGL(fwd, dim3(grid), dim3(512), LDS_BYTES, stream, a); } }
    const hipError_t le = hipPeekAtLastError();
    if (le != hipSuccess) fprintf(stderr, "kernel_launch: launch failed: %s\n", hipGetErrorName(le));
}
```
